# Optimizing an MI355X kernel written in HIP

```python
import math
import jax
import jax.numpy as jnp
from jax import lax
import numpy as np

D_MODEL = 1024
BATCH = 8
SEQ = 4096
DEPTH = 4

GRID_W = 64
CTX_LEN = 256
N_MIXERS = 3
D_FF = 4 * D_MODEL
EPS = 1e-6
ROPE_THETA = 10000.0
Q_BLOCK = 128
NEG_INF = -1e30

A_HEADS = 16
A_KV_HEADS = 4
A_GROUP = A_HEADS // A_KV_HEADS
A_HEAD_DIM = D_MODEL // A_HEADS
WINDOW = 128
B_HEADS = 8
B_HEAD_DIM = D_MODEL // (2 * B_HEADS)
C_HEADS = 16
C_Q_LORA = 384
C_KV_LORA = 256
C_NOPE = 64
C_ROPE = 32
C_V = 64

kernel_name = "hybrid_interleaved_diffusion_trunk"


def rms_norm(x, g):
    x32 = x.astype(jnp.float32)
    y = x32 * lax.rsqrt(jnp.mean(x32 * x32, axis=-1, keepdims=True) + EPS)
    return (y * g.astype(jnp.float32)).astype(x.dtype)


def modulate(x, shift, scale):
    return x * (1.0 + scale) + shift


def rope_2d(x, rows, cols):
    d = x.shape[-1]
    da = d // 2
    inv = ROPE_THETA ** (-jnp.arange(0, da, 2, dtype=jnp.float32) / da)
    shape = (1, x.shape[1]) + (1,) * (x.ndim - 3) + (da // 2,)

    def rot(xa, pos):
        ang = pos.astype(jnp.float32)[:, None] * inv[None, :]
        cos = jnp.cos(ang).reshape(shape).astype(x.dtype)
        sin = jnp.sin(ang).reshape(shape).astype(x.dtype)
        x1, x2 = jnp.split(xa, 2, axis=-1)
        return jnp.concatenate([x1 * cos - x2 * sin, x2 * cos + x1 * sin], axis=-1)

    return jnp.concatenate([rot(x[..., :da], rows), rot(x[..., da:], cols)], axis=-1)


def softmax_with_sink(s, sink):
    if sink is None:
        return jax.nn.softmax(s, axis=-1)
    col = jnp.broadcast_to(sink.astype(jnp.float32)[None, :, :, None, None], s.shape[:-1] + (1,))
    return jax.nn.softmax(jnp.concatenate([s, col], axis=-1), axis=-1)[..., :-1]


def dense_attention(q, k, v, scale, sink=None):
    B, Sq, G, R, dq = q.shape
    dv = v.shape[-1]
    nb = Sq // Q_BLOCK
    qb = jnp.moveaxis(q.reshape(B, nb, Q_BLOCK, G, R, dq), 1, 0)

    def block(qi):
        s = jnp.einsum("bqgrd,bkgd->bgrqk", qi, k).astype(jnp.float32) * scale
        p = softmax_with_sink(s, sink).astype(v.dtype)
        return jnp.einsum("bgrqk,bkgv->bqgrv", p, v)

    out = lax.map(block, qb)
    return jnp.moveaxis(out, 0, 1).reshape(B, Sq, G, R, dv)


def window_attention(q, k, v, kc, vc, scale, sink):
    B, S, G, R, dq = q.shape
    dv = v.shape[-1]
    nb = S // Q_BLOCK
    span = Q_BLOCK + 2 * WINDOW
    pad = ((0, 0), (WINDOW, WINDOW), (0, 0), (0, 0))
    kp = jnp.pad(k, pad)
    vp = jnp.pad(v, pad)
    qb = jnp.moveaxis(q.reshape(B, nb, Q_BLOCK, G, R, dq), 1, 0)
    offs = jnp.arange(span) - WINDOW
    band = jnp.abs(jnp.arange(Q_BLOCK)[:, None] - offs[None, :]) <= WINDOW

    def block(args):
        i, qi = args
        start = i * Q_BLOCK
        ki = lax.dynamic_slice_in_dim(kp, start, span, axis=1)
        vi = lax.dynamic_slice_in_dim(vp, start, span, axis=1)
        kpos = start + offs
        mask = band & ((kpos >= 0) & (kpos < S))[None, :]
        s_loc = jnp.einsum("bqgrd,bkgd->bgrqk", qi, ki).astype(jnp.float32) * scale
        s_loc = jnp.where(mask, s_loc, NEG_INF)
        s_ctx = jnp.einsum("bqgrd,bcgd->bgrqc", qi, kc).astype(jnp.float32) * scale
        p = softmax_with_sink(jnp.concatenate([s_loc, s_ctx], axis=-1), sink).astype(v.dtype)
        return (jnp.einsum("bgrqk,bkgv->bqgrv", p[..., :span], vi)
                + jnp.einsum("bgrqc,bcgv->bqgrv", p[..., span:], vc))

    out = lax.map(block, (jnp.arange(nb), qb))
    return jnp.moveaxis(out, 0, 1).reshape(B, S, G, R, dv)


def mixer_window_gqa(u, uc, p, rows, cols, layer_idx, need_ctx):
    B, S, _ = u.shape
    C = uc.shape[1]
    nq = A_HEADS * A_HEAD_DIM
    nk = A_KV_HEADS * A_HEAD_DIM
    scale = A_HEAD_DIM ** -0.5
    sink = p["sink"].reshape(A_KV_HEADS, A_GROUP)
    q, k, v = jnp.split(u @ p["w_qkv"], [nq, nq + nk], axis=-1)
    q = rope_2d(q.reshape(B, S, A_KV_HEADS, A_GROUP, A_HEAD_DIM), rows, cols)
    k = rope_2d(k.reshape(B, S, A_KV_HEADS, A_HEAD_DIM), rows, cols)
    v = v.reshape(B, S, A_KV_HEADS, A_HEAD_DIM)
    kc, vc = jnp.split(uc @ p["w_qkv"][:, nq:], 2, axis=-1)
    kc = kc.reshape(B, C, A_KV_HEADS, A_HEAD_DIM)
    vc = vc.reshape(B, C, A_KV_HEADS, A_HEAD_DIM)
    y = window_attention(q, k, v, kc, vc, scale, sink).reshape(B, S, nq) @ p["w_o"]
    yc = None
    if need_ctx:
        qc = (uc @ p["w_qkv"][:, :nq]).reshape(B, C, A_KV_HEADS, A_GROUP, A_HEAD_DIM)
        yc = dense_attention(qc, kc, vc, scale, sink).reshape(B, C, nq) @ p["w_o"]
    return y, yc


def mixer_diff_attention(u, uc, p, rows, cols, layer_idx, need_ctx):
    B, S, _ = u.shape
    C = uc.shape[1]
    d = B_HEAD_DIM
    nqk = B_HEADS * 2 * d
    scale = d ** -0.5
    lam_init = 0.8 - 0.6 * math.exp(-0.3 * layer_idx)
    lam = p["lambda"].astype(jnp.float32)
    lam_full = jnp.exp(jnp.sum(lam[0] * lam[1])) - jnp.exp(jnp.sum(lam[2] * lam[3])) + lam_init
    q, k, v = jnp.split(u @ p["w_qkv"], [nqk, 2 * nqk], axis=-1)
    q = rope_2d(q.reshape(B, S, B_HEADS, 2, d), rows, cols)
    k = rope_2d(k.reshape(B, S, B_HEADS, 2, d), rows, cols)
    v = v.reshape(B, S, B_HEADS, 2 * d)
    kc, vc = jnp.split(uc @ p["w_qkv"][:, nqk:], 2, axis=-1)
    kc = kc.reshape(B, C, B_HEADS, 2, d)
    vc = vc.reshape(B, C, B_HEADS, 2 * d)

    def diff_attend(qq, kk, vv):
        a1 = dense_attention(qq[:, :, :, 0:1], kk[:, :, :, 0], vv, scale)
        a2 = dense_attention(qq[:, :, :, 1:2], kk[:, :, :, 1], vv, scale)
        o = a1[:, :, :, 0] - lam_full.astype(a1.dtype) * a2[:, :, :, 0]
        o = rms_norm(o, p["subln"]) * (1.0 - lam_init)
        return o.reshape(o.shape[0], o.shape[1], -1) @ p["w_o"]

    y = diff_attend(q, jnp.concatenate([k, kc], axis=1), jnp.concatenate([v, vc], axis=1))
    yc = None
    if need_ctx:
        qc = (uc @ p["w_qkv"][:, :nqk]).reshape(B, C, B_HEADS, 2, d)
        yc = diff_attend(qc, kc, vc)
    return y, yc


def mixer_mla(u, uc, p, rows, cols, layer_idx, need_ctx):
    B, S, _ = u.shape
    C = uc.shape[1]
    dqk = C_NOPE + C_ROPE
    scale = dqk ** -0.5

    def queries(cq):
        n = cq.shape[1]
        return (rms_norm(cq, p["q_norm"]) @ p["w_uq"]).reshape(B, n, C_HEADS, dqk)

    def keys_values(ckv, kr):
        n = ckv.shape[1]
        kv = (rms_norm(ckv, p["kv_norm"]) @ p["w_ukv"]).reshape(B, n, C_HEADS, C_NOPE + C_V)
        k = jnp.concatenate([kv[..., :C_NOPE], jnp.broadcast_to(kr, (B, n, C_HEADS, C_ROPE))], axis=-1)
        return k, kv[..., C_NOPE:]

    cq, ckv, kr = jnp.split(u @ p["w_in"], [C_Q_LORA, C_Q_LORA + C_KV_LORA], axis=-1)
    q = queries(cq)
    q = jnp.concatenate([q[..., :C_NOPE], rope_2d(q[..., C_NOPE:], rows, cols)], axis=-1)
    k, v = keys_values(ckv, rope_2d(kr[:, :, None, :], rows, cols))
    ckv_c, kr_c = jnp.split(uc @ p["w_in"][:, C_Q_LORA:], [C_KV_LORA], axis=-1)
    kc, vc = keys_values(ckv_c, kr_c[:, :, None, :])
    y = dense_attention(q[:, :, :, None], jnp.concatenate([k, kc], axis=1),
                        jnp.concatenate([v, vc], axis=1), scale)
    y = y.reshape(B, S, C_HEADS * C_V) @ p["w_o"]
    yc = None
    if need_ctx:
        qc = queries(uc @ p["w_in"][:, :C_Q_LORA])
        yc = dense_attention(qc[:, :, :, None], kc, vc, scale).reshape(B, C, C_HEADS * C_V) @ p["w_o"]
    return y, yc


def squared_relu_mlp(u, w1, w2):
    h = jax.nn.relu(u @ w1)
    return (h * h) @ w2


def setup_inputs(seed: int = 0) -> dict:
    key = jax.random.key(seed)
    keys = iter(jax.random.split(key, 128))

    def normal(shape, scale=1.0):
        return jax.random.normal(next(keys), shape, jnp.float32) * scale

    inp = {
        "x": normal((BATCH, SEQ, D_MODEL)),
        "c": normal((BATCH, D_MODEL)),
        "ctx": normal((BATCH, CTX_LEN, D_MODEL)),
        "c_ctx": normal((D_MODEL,)),
    }
    for i in range(DEPTH):
        kind = i % N_MIXERS
        inp[f"l{i}_ada_w"] = normal((D_MODEL, 6 * D_MODEL), 0.5 * D_MODEL ** -0.5)
        inp[f"l{i}_ada_b"] = normal((6 * D_MODEL,), 0.02)
        inp[f"l{i}_norms"] = 1.0 + normal((4, D_MODEL), 0.05)
        if kind == 0:
            inp[f"l{i}_w_qkv"] = normal((D_MODEL, (A_HEADS + 2 * A_KV_HEADS) * A_HEAD_DIM), D_MODEL ** -0.5)
            inp[f"l{i}_sink"] = normal((A_HEADS,), 0.5)
            inp[f"l{i}_w_o"] = normal((A_HEADS * A_HEAD_DIM, D_MODEL), (A_HEADS * A_HEAD_DIM) ** -0.5)
        elif kind == 1:
            inp[f"l{i}_w_qkv"] = normal((D_MODEL, 3 * B_HEADS * 2 * B_HEAD_DIM), D_MODEL ** -0.5)
            inp[f"l{i}_lambda"] = normal((4, B_HEAD_DIM), 0.1)
            inp[f"l{i}_subln"] = 1.0 + normal((2 * B_HEAD_DIM,), 0.05)
            inp[f"l{i}_w_o"] = normal((B_HEADS * 2 * B_HEAD_DIM, D_MODEL), (B_HEADS * 2 * B_HEAD_DIM) ** -0.5)
        else:
            inp[f"l{i}_w_in"] = normal((D_MODEL, C_Q_LORA + C_KV_LORA + C_ROPE), D_MODEL ** -0.5)
            inp[f"l{i}_q_norm"] = 1.0 + normal((C_Q_LORA,), 0.05)
            inp[f"l{i}_kv_norm"] = 1.0 + normal((C_KV_LORA,), 0.05)
            inp[f"l{i}_w_uq"] = normal((C_Q_LORA, C_HEADS * (C_NOPE + C_ROPE)), C_Q_LORA ** -0.5)
            inp[f"l{i}_w_ukv"] = normal((C_KV_LORA, C_HEADS * (C_NOPE + C_V)), C_KV_LORA ** -0.5)
            inp[f"l{i}_w_o"] = normal((C_HEADS * C_V, D_MODEL), (C_HEADS * C_V) ** -0.5)
        inp[f"l{i}_mlp_w1"] = normal((D_MODEL, D_FF), D_MODEL ** -0.5)
        inp[f"l{i}_mlp_w2"] = normal((D_FF, D_MODEL), D_FF ** -0.5)
    return inp


def reference(x, c, ctx, c_ctx,
              l0_ada_w, l0_ada_b, l0_norms, l0_w_qkv, l0_sink, l0_w_o, l0_mlp_w1, l0_mlp_w2,
              l1_ada_w, l1_ada_b, l1_norms, l1_w_qkv, l1_lambda, l1_subln, l1_w_o, l1_mlp_w1, l1_mlp_w2,
              l2_ada_w, l2_ada_b, l2_norms, l2_w_in, l2_q_norm, l2_kv_norm, l2_w_uq, l2_w_ukv, l2_w_o,
              l2_mlp_w1, l2_mlp_w2,
              l3_ada_w, l3_ada_b, l3_norms, l3_w_qkv, l3_sink, l3_w_o, l3_mlp_w1, l3_mlp_w2):
    B, S, D = x.shape
    ROWS = S // GRID_W
    rows = jnp.repeat(jnp.arange(ROWS, dtype=jnp.int32), GRID_W)
    cols = jnp.tile(jnp.arange(GRID_W, dtype=jnp.int32), ROWS)

    layers = [
        dict(ada_w=l0_ada_w, ada_b=l0_ada_b, norms=l0_norms, w_qkv=l0_w_qkv, sink=l0_sink, w_o=l0_w_o,
             mlp_w1=l0_mlp_w1, mlp_w2=l0_mlp_w2),
        dict(ada_w=l1_ada_w, ada_b=l1_ada_b, norms=l1_norms, w_qkv=l1_w_qkv, subln=l1_subln, w_o=l1_w_o,
             mlp_w1=l1_mlp_w1, mlp_w2=l1_mlp_w2, **{"lambda": l1_lambda}),
        dict(ada_w=l2_ada_w, ada_b=l2_ada_b, norms=l2_norms, w_in=l2_w_in, q_norm=l2_q_norm,
             kv_norm=l2_kv_norm, w_uq=l2_w_uq, w_ukv=l2_w_ukv, w_o=l2_w_o,
             mlp_w1=l2_mlp_w1, mlp_w2=l2_mlp_w2),
        dict(ada_w=l3_ada_w, ada_b=l3_ada_b, norms=l3_norms, w_qkv=l3_w_qkv, sink=l3_sink, w_o=l3_w_o,
             mlp_w1=l3_mlp_w1, mlp_w2=l3_mlp_w2),
    ]
    mixers = (mixer_window_gqa, mixer_diff_attention, mixer_mla)

    sc = jax.nn.silu(c)
    scc = jax.nn.silu(c_ctx)
    h, hc = x, ctx
    for i in range(DEPTH):
        p = layers[i]
        last = i == DEPTH - 1
        g = p["norms"]
        mod = jnp.split((sc @ p["ada_w"] + p["ada_b"])[:, None, :], 6, axis=-1)
        n_mod_c = 2 if last else 6
        mod_c = jnp.split(scc @ p["ada_w"][:, :n_mod_c * D] + p["ada_b"][:n_mod_c * D], n_mod_c, axis=-1)

        u = modulate(rms_norm(h, g[0]), mod[0], mod[1])
        uc = modulate(rms_norm(hc, g[0]), mod_c[0], mod_c[1])
        y, yc = mixers[i % N_MIXERS](u, uc, p, rows, cols, i, not last)
        h = h + mod[2] * rms_norm(y, g[1])
        u = modulate(rms_norm(h, g[2]), mod[3], mod[4])
        h = h + mod[5] * rms_norm(squared_relu_mlp(u, p["mlp_w1"], p["mlp_w2"]), g[3])
        if not last:
            hc = hc + mod_c[2] * rms_norm(yc, g[1])
            uc = modulate(rms_norm(hc, g[2]), mod_c[3], mod_c[4])
            hc = hc + mod_c[5] * rms_norm(squared_relu_mlp(uc, p["mlp_w1"], p["mlp_w2"]), g[3])
    return h
```

```cpp
#include <hip/hip_runtime.h>
#include <hip/hip_cooperative_groups.h>
#include <cstdio>
#include <cstdint>
namespace cg = cooperative_groups;
namespace pg8 {
#define PG8_LAS __attribute__((address_space(3)))
typedef unsigned short bf16_t;
typedef short bf16x8 __attribute__((ext_vector_type(8)));
typedef float f32x4 __attribute__((ext_vector_type(4)));
typedef unsigned u32x4 __attribute__((ext_vector_type(4)));
constexpr int BM = 256, BK = 64, HALF = 128, HTB = HALF * BK * 2  , STAGE_BYTES = 8 * HTB, NXCD = 8, WGM = 8;

__host__ __device__ __forceinline__ int lds_byte(int r, int c) { const int st = (r >> 4) * 2 + (c >> 5), rr = r & 15, cc = c & 31, ob = rr * 64 + cc * 2; return st * 1024 + (ob ^ (((ob >> 9) & 1) << 5)); }
__host__ __device__ __forceinline__ void stage_rc(int b, int& R, int& C) { const int st = b / 1024, sb = b % 1024, swz = sb ^ (((sb >> 9) & 1) << 5); R = (st >> 1) * 16 + swz / 64; C = (st & 1) * 32 + (swz % 64) / 2; }
__host__ __device__ __forceinline__ int perm32(int rho) { const int n = rho >> 4, i = rho & 15; return 8 * (i >> 2) + 4 * n + (i & 3); }

struct Unit { int pm, pn; };
struct Gemm { const bf16_t* A; const bf16_t* Bt; int M, N, K, lda, ldb; };

struct StaticOrder {
    int nM, nN, nwg, G, c;
    __host__ __device__ void init(int M, int N, int G_, int c_) { nM = M / BM; nN = N / BM; nwg = nM * nN; G = G_; c = c_; }
    __host__ __device__ bool next(int i, Unit& u) const {
        const int L = i * G + c; if (L >= nwg) return false;
        int wgid = L; { const int q = nwg / NXCD, r = nwg % NXCD, xcd = wgid % NXCD, off = wgid / NXCD; wgid = (xcd < r ? xcd * (q + 1) : r * (q + 1) + (xcd - r) * q) + off; }
        const int nig = WGM * nN, gid = wgid / nig, fm = gid * WGM, gsz = (nM - fm) < WGM ? (nM - fm) : WGM;
        u.pm = fm + ((wgid % nig) % gsz); u.pn = (wgid % nig) / gsz; return true;
    }
    __device__ __forceinline__ void a_ready(const Unit&) const {}
    __device__ __forceinline__ void done(const Unit&) const {}
};

__device__ __forceinline__ unsigned cvt_pk_bf16(float lo, float hi) { unsigned r; asm volatile("v_cvt_pk_bf16_f32 %0, %1, %2" : "=v"(r) : "v"(lo), "v"(hi)); return r; }
typedef float f32x2 __attribute__((ext_vector_type(2)));
__device__ __forceinline__ unsigned pk2e(float lo, float hi) { typedef float v2f __attribute__((ext_vector_type(2))); typedef __bf16 v2b __attribute__((ext_vector_type(2))); v2f v = {lo, hi}; v2b b = __builtin_convertvector(v, v2b); return __builtin_bit_cast(unsigned, b); }
struct EpiStore {
    static constexpr bool PERM = true, AFTER_DRAIN = false;
    bf16_t* O0; int ld0; int split_col; bf16_t* O1; int ld1; int act;
    __device__ __forceinline__ void operator()(const f32x4 (&acc)[2][2][4][2], const Unit& u, int wr, int wc, int fr_, int fq_) const {
        int ln_ = threadIdx.x & 63; asm volatile("" : "+v"(ln_)); const int fr = ln_ & 15, fq = ln_ >> 4; (void)fr_; (void)fq_;
        const int row0 = u.pm * BM + wr * 64 + fr; int colt = u.pn * BM; bf16_t* base = O0; int ld = ld0;
        if (split_col && colt >= split_col) { base = O1; ld = ld1; colt -= split_col; }
        const int col0 = colt + wc * 32 + 8 * fq;
#pragma unroll
        for (int ai = 0; ai < 2; ++ai)
#pragma unroll
            for (int m = 0; m < 4; ++m) { bf16_t* rowp = base + (size_t)(row0 + ai * HALF + m * 16) * ld + col0;
#pragma unroll
                for (int bj = 0; bj < 2; ++bj) { f32x4 v0 = acc[ai][bj][m][0], v1 = acc[ai][bj][m][1];
                    if (act) {
#pragma unroll
                        for (int e = 0; e < 4; ++e) { float a = v0[e] > 0.f ? v0[e] : 0.f; v0[e] = a * a; float b = v1[e] > 0.f ? v1[e] : 0.f; v1[e] = b * b; } }
                    u32x4 w; w.x = pk2e(v0[0], v0[1]); w.y = pk2e(v0[2], v0[3]); w.z = pk2e(v1[0], v1[1]); w.w = pk2e(v1[2], v1[3]);
                    *(u32x4*)(rowp + bj * HALF) = w; } }
    }
};
template <int MODE> struct EpiRope {
    static constexpr bool PERM = false, AFTER_DRAIN = false;
    bf16_t* O0; int ld0; int split_col; bf16_t* O1; int ld1; float qscale; const float* tab; int tlat;
    __device__ __forceinline__ void operator()(const f32x4 (&acc)[2][2][4][2], const Unit& u, int wr, int wc, int fr_, int fq_) const {
        int ln_ = threadIdx.x & 63; asm volatile("" : "+v"(ln_)); const int fr = ln_ & 15, fq = ln_ >> 4; (void)fr_; (void)fq_;
        typedef unsigned u32x2v __attribute__((ext_vector_type(2)));
        int colt = u.pn * BM; bf16_t* base = O0; int ld = ld0; float sc = qscale;
        const int gcolt = colt;
        if (split_col && colt >= split_col) { base = O1; ld = ld1; colt -= split_col; sc = 1.f; }
#pragma unroll
        for (int ai = 0; ai < 2; ++ai)
#pragma unroll
            for (int m = 0; m < 4; ++m) {
                const int row = u.pm * BM + ai * HALF + wr * 64 + m * 16 + fr;
                const bool lat = row < tlat; const int s = row & 4095, prow = s >> 6, pcol = s & 63;
                bf16_t* rowp = base + (size_t)row * ld + colt + wc * 32 + 4 * fq;
#pragma unroll
                for (int bj = 0; bj < 2; ++bj) {
                    if (MODE == 0) {
                        const int pos = (wc & 1) ? pcol : prow;
                        const f32x4* tp = (const f32x4*)(tab + (size_t)(pos * 16 + 4 * fq) * 2);
                        const f32x4 t0 = tp[0], t1 = tp[1];
                        const f32x4 x1 = acc[ai][bj][m][0], x2 = acc[ai][bj][m][1];
                        const float cs[4] = {t0[0], t0[2], t1[0], t1[2]}, sn[4] = {t0[1], t0[3], t1[1], t1[3]};
                        float o1[4], o2[4];
#pragma unroll
                        for (int e = 0; e < 4; ++e) { o1[e] = lat ? x1[e] * cs[e] - x2[e] * sn[e] : x1[e]; o2[e] = lat ? x2[e] * cs[e] + x1[e] * sn[e] : x2[e]; o1[e] *= sc; o2[e] *= sc; }
                        u32x2v w1, w2; w1.x = pk2e(o1[0], o1[1]); w1.y = pk2e(o1[2], o1[3]); w2.x = pk2e(o2[0], o2[1]); w2.y = pk2e(o2[2], o2[3]);
                        *(u32x2v*)(rowp + bj * HALF) = w1; *(u32x2v*)(rowp + bj * HALF + 16) = w2;
                    } else {
#pragma unroll
                        for (int n = 0; n < 2; ++n) {
                            const int c0 = gcolt + bj * HALF + wc * 32 + 16 * n; const int cc = c0 % 96;
                            const f32x4 x = acc[ai][bj][m][n]; float o[4] = {x[0], x[1], x[2], x[3]};
                            if (cc >= 64) {
                                const int pos = (cc >= 80) ? pcol : prow;
                                const f32x4* tp = (const f32x4*)(tab + (size_t)(pos * 8 + 4 * (fq & 1)) * 2);
                                const f32x4 t0 = tp[0], t1 = tp[1];
                                const float cs[4] = {t0[0], t0[2], t1[0], t1[2]}, sn[4] = {t0[1], t0[3], t1[1], t1[3]};
#pragma unroll
                                for (int e = 0; e < 4; ++e) { const float p = __shfl_xor(x[e], 32); const float r = (fq < 2) ? x[e] * cs[e] - p * sn[e] : x[e] * cs[e] + p * sn[e]; o[e] = lat ? r : x[e]; }
                            }
                            u32x2v w; w.x = pk2e(o[0] * sc, o[1] * sc); w.y = pk2e(o[2] * sc, o[3] * sc);
                            *(u32x2v*)(rowp + bj * HALF + 16 * n) = w;
                        }
                    }
                }
            }
    }
};
__device__ __forceinline__ float epi_shx(float v, int o, int lane) { return __int_as_float(__builtin_amdgcn_ds_bpermute((lane ^ o) << 2, __float_as_int(v))); }
struct EpiFuse {
    static constexpr bool PERM = true, AFTER_DRAIN = false;
    const float* hin; float* hout; bf16_t* U;
    const float* gY; const float* gate; const float* gU; const float* scale; const float* shift;
    float* X; unsigned* cnt; unsigned target0; PG8_LAS unsigned char* scr; float eps;
    __device__ __forceinline__ void xchg(const float (&ss)[2][4], float (&rs)[2][4], const Unit& u, int wr, int wc, int fr, int fq, int tid, int which) const {
        PG8_LAS float* P = (PG8_LAS float*)scr; PG8_LAS float* S = (PG8_LAS float*)(scr + 4096);
        if (fq == 0) {
#pragma unroll
            for (int ai = 0; ai < 2; ++ai)
#pragma unroll
                for (int m = 0; m < 4; ++m) P[(ai * 128 + wr * 64 + m * 16 + fr) * 4 + wc] = ss[ai][m]; }
        asm volatile("s_waitcnt lgkmcnt(0)" ::: "memory"); __builtin_amdgcn_s_barrier(); asm volatile("" ::: "memory");
        float* Xe = X + (size_t)which * (128 * 4 * 256) + (size_t)u.pm * 1024;
        unsigned* c = cnt + 64 * u.pm;
        if (tid < 256) { const f32x4 p = *(const PG8_LAS f32x4*)(P + tid * 4);
            __hip_atomic_store(Xe + u.pn * 256 + tid, (p[0] + p[1]) + (p[2] + p[3]), __ATOMIC_RELAXED, __HIP_MEMORY_SCOPE_AGENT); }
        asm volatile("s_waitcnt vmcnt(0)" ::: "memory");
        if (tid < 256 && (tid & 63) == 0) __hip_atomic_fetch_add(c, 1u, __ATOMIC_RELAXED, __HIP_MEMORY_SCOPE_AGENT);
        if (tid < 64) { const unsigned want = target0 + 16u * (unsigned)which; unsigned spins = 0;
            while ((unsigned)__builtin_amdgcn_readfirstlane(__hip_atomic_load(c, __ATOMIC_RELAXED, __HIP_MEMORY_SCOPE_AGENT)) < want) { __builtin_amdgcn_s_sleep(1); if (++spins > (1u << 20)) break; }
            __builtin_amdgcn_fence(__ATOMIC_ACQUIRE, "agent"); }
        asm volatile("s_waitcnt vmcnt(0) lgkmcnt(0)" ::: "memory"); __builtin_amdgcn_s_barrier(); asm volatile("" ::: "memory");
        if (tid < 256) { float t = 0.f;
#pragma unroll
            for (int q = 0; q < 4; ++q) t += __hip_atomic_load(Xe + q * 256 + tid, __ATOMIC_RELAXED, __HIP_MEMORY_SCOPE_AGENT);
            S[tid] = 1.0f / sqrtf(t * (1.f / 1024.f) + eps); }
        asm volatile("s_waitcnt vmcnt(0) lgkmcnt(0)" ::: "memory"); __builtin_amdgcn_s_barrier(); asm volatile("" ::: "memory");
#pragma unroll
        for (int ai = 0; ai < 2; ++ai)
#pragma unroll
            for (int m = 0; m < 4; ++m) rs[ai][m] = S[ai * 128 + wr * 64 + m * 16 + fr];
        asm volatile("s_waitcnt lgkmcnt(0)" ::: "memory");
    }
    __device__ __forceinline__ void operator()(f32x4 (&acc)[2][2][4][2], const Unit& u, int wr, int wc, int fr_, int fq_) const {
        int tid = threadIdx.x; asm volatile("" : "+v"(tid)); const int ln = tid & 63, fr = ln & 15, fq = ln >> 4; (void)fr_; (void)fq_;
        const int b = (u.pm * BM) >> 12; const int colb = u.pn * BM + wc * 32 + 8 * fq; const int row0 = u.pm * BM + wr * 64 + fr;
        float ss[2][4], rs[2][4];
#pragma unroll
        for (int ai = 0; ai < 2; ++ai)
#pragma unroll
            for (int m = 0; m < 4; ++m) { float s = 0.f;
#pragma unroll
                for (int bj = 0; bj < 2; ++bj)
#pragma unroll
                    for (int n = 0; n < 2; ++n) { const f32x4 v = acc[ai][bj][m][n]; s += (v[0] * v[0] + v[1] * v[1]) + (v[2] * v[2] + v[3] * v[3]); }
                s += epi_shx(s, 16, ln); s += epi_shx(s, 32, ln); ss[ai][m] = s; }
        f32x4 H[2][2][2];
#define EF_LOADH(ai_, mp_) do { _Pragma("unroll") for (int mm = 0; mm < 2; ++mm) { const size_t ro_ = (size_t)(row0 + (ai_) * HALF + (2 * (mp_) + mm) * 16) * 1024 + colb; \
            _Pragma("unroll") for (int bj = 0; bj < 2; ++bj) _Pragma("unroll") for (int n = 0; n < 2; ++n) H[mm][bj][n] = *(const f32x4*)(hin + ro_ + bj * HALF + 4 * n); } } while (0)
        EF_LOADH(0, 0);
        xchg(ss, rs, u, wr, wc, fr, fq, tid, 0);
        { f32x4 G[2][2];
#pragma unroll
          for (int bj = 0; bj < 2; ++bj)
#pragma unroll
              for (int n = 0; n < 2; ++n) G[bj][n] = *(const f32x4*)(gate + (size_t)b * 6144 + colb + bj * HALF + 4 * n) * *(const f32x4*)(gY + colb + bj * HALF + 4 * n);
#pragma unroll
          for (int ai = 0; ai < 2; ++ai)
#pragma unroll
              for (int mp = 0; mp < 2; ++mp) {
                  if (ai + mp > 0) EF_LOADH(ai, mp);
#pragma unroll
                  for (int mm = 0; mm < 2; ++mm) { const int m = 2 * mp + mm; const size_t ro = (size_t)(row0 + ai * HALF + m * 16) * 1024 + colb; float s = 0.f;
#pragma unroll
                      for (int bj = 0; bj < 2; ++bj)
#pragma unroll
                          for (int n = 0; n < 2; ++n) { const f32x4 v = H[mm][bj][n] + G[bj][n] * (acc[ai][bj][m][n] * rs[ai][m]);
                              *(f32x4*)(hout + ro + bj * HALF + 4 * n) = v; acc[ai][bj][m][n] = v; s += (v[0] * v[0] + v[1] * v[1]) + (v[2] * v[2] + v[3] * v[3]); }
                      s += epi_shx(s, 16, ln); s += epi_shx(s, 32, ln); ss[ai][m] = s; } } }
#undef EF_LOADH
        if (U) {
            xchg(ss, rs, u, wr, wc, fr, fq, tid, 1);
            f32x4 A2[2][2], B2[2][2];
#pragma unroll
            for (int bj = 0; bj < 2; ++bj)
#pragma unroll
                for (int n = 0; n < 2; ++n) { A2[bj][n] = *(const f32x4*)(gU + colb + bj * HALF + 4 * n) * (*(const f32x4*)(scale + (size_t)b * 6144 + colb + bj * HALF + 4 * n) + 1.f);
                    B2[bj][n] = *(const f32x4*)(shift + (size_t)b * 6144 + colb + bj * HALF + 4 * n); }
#pragma unroll
            for (int ai = 0; ai < 2; ++ai)
#pragma unroll
                for (int m = 0; m < 4; ++m) { bf16_t* up = U + (size_t)(row0 + ai * HALF + m * 16) * 1024 + colb;
#pragma unroll
                    for (int bj = 0; bj < 2; ++bj) { const f32x4 v0 = (acc[ai][bj][m][0] * rs[ai][m]) * A2[bj][0] + B2[bj][0], v1 = (acc[ai][bj][m][1] * rs[ai][m]) * A2[bj][1] + B2[bj][1];
                        u32x4 w; w.x = pk2e(v0[0], v0[1]); w.y = pk2e(v0[2], v0[3]); w.z = pk2e(v1[0], v1[1]); w.w = pk2e(v1[2], v1[3]); *(u32x4*)(up + bj * HALF) = w; } }
        }
    }
};
template <class Epi, class Sched, bool ALIGN_EPI = false, bool SP2 = false>
__device__ __forceinline__ void gemm_phase(PG8_LAS unsigned char* lds, const Gemm g, const Sched& S, const Epi& E) {
    int tid_l = threadIdx.x; asm volatile("" : "+v"(tid_l)); const int tid = tid_l, wid = __builtin_amdgcn_readfirstlane(tid >> 6), lane = tid & 63, wr = wid >> 2, wc = wid & 3, fr = lane & 15, fq = lane >> 4;
    const int K = g.K, nt = K / BK;
    unsigned voffA[2], voffB[2];
#pragma unroll
    for (int i = 0; i < 2; ++i) { int R, C; stage_rc(tid * 16 + i * 8192, R, C); const int Rb = Epi::PERM ? ((R & ~31) + perm32(R & 31)) : R;
        voffA[i] = (unsigned)(R * g.lda + C) * 2u; voffB[i] = (unsigned)(Rb * g.ldb + C) * 2u; }
    const size_t kstep = (size_t)(BK * 2);
    const size_t hstepA = (size_t)HALF * g.lda * 2, hstepB = (size_t)HALF * g.ldb * 2;
    const size_t tstepA = 2 * hstepA, tstepB = 2 * hstepB;
    const unsigned ldsw = (unsigned)wid * 1024u;
    const int aoff = lds_byte(wr * 64 + fr, fq * 8), boff = lds_byte(wc * 32 + fr, fq * 8);
#define PG8_SA(b, h) (((b) * 2 + (h)) * HTB)
#define PG8_SB(b, h) ((4 + (b) * 2 + (h)) * HTB)
#define PG8_STAGE(bufoff, gbase, voff) do { _Pragma("unroll") for (int _i = 0; _i < 2; ++_i) \
        __builtin_amdgcn_global_load_lds((const unsigned*)((const char*)(gbase) + (voff)[_i]), (PG8_LAS unsigned*)(lds + (bufoff) + ldsw + _i * 8192), 16, 0, 0); } while (0)
#define PG8_LDA(dst, b, h) do { _Pragma("unroll") for (int m = 0; m < 4; ++m) _Pragma("unroll") for (int k = 0; k < 2; ++k) dst[m][k] = *(const PG8_LAS bf16x8*)(lds + PG8_SA(b, h) + aoff + m * 2048 + k * 1024); } while (0)
#define PG8_LDB(dst, b, h) do { _Pragma("unroll") for (int n = 0; n < 2; ++n) _Pragma("unroll") for (int k = 0; k < 2; ++k) dst[n][k] = *(const PG8_LAS bf16x8*)(lds + PG8_SB(b, h) + boff + n * 2048 + k * 1024); } while (0)
#define PG8_MMA(ai, bj, At, Bt) do { __builtin_amdgcn_s_setprio(1); _Pragma("unroll") for (int m = 0; m < 4; ++m) _Pragma("unroll") for (int n = 0; n < 2; ++n) _Pragma("unroll") for (int k = 0; k < 2; ++k) \
        acc[ai][bj][m][n] = __builtin_amdgcn_mfma_f32_16x16x32_bf16(Bt[n][k], At[m][k], acc[ai][bj][m][n], 0, 0, 0); __builtin_amdgcn_s_setprio(0); } while (0)
#define PG8_WAIT_V(n) asm volatile("s_waitcnt vmcnt(" #n ")" ::: "memory")
#define PG8_WAIT_L(n) asm volatile("s_waitcnt lgkmcnt(" #n ")" ::: "memory")
#define PG8_BAR __builtin_amdgcn_s_barrier()
#define PG8_SCHED __builtin_amdgcn_sched_barrier(0)
    Unit cur, nxt; int ui = 0;
    if (!S.next(0, cur)) return;
    f32x4 acc[2][2][4][2];
#pragma unroll
    for (int a = 0; a < 2; ++a)
#pragma unroll
        for (int b = 0; b < 2; ++b)
#pragma unroll
            for (int m = 0; m < 4; ++m)
#pragma unroll
                for (int n = 0; n < 2; ++n) acc[a][b][m][n] = (f32x4){0.f, 0.f, 0.f, 0.f};
    bf16x8 At[4][2], B0[2][2], B1[2][2];
    const char* cA = (const char*)g.A + (size_t)cur.pm * tstepA; const char* cB = (const char*)g.Bt + (size_t)cur.pn * tstepB;
    S.a_ready(cur);
    if constexpr (SP2) {
        PG8_STAGE(PG8_SB(0, 0), cB, voffB); PG8_STAGE(PG8_SB(0, 1), cB + hstepB, voffB); PG8_STAGE(PG8_SA(0, 0), cA, voffA); PG8_STAGE(PG8_SA(0, 1), cA + hstepA, voffA);
        if (wr == 1) PG8_BAR;
        PG8_WAIT_V(2); PG8_BAR;
        PG8_STAGE(PG8_SB(1, 0), cB + kstep, voffB); PG8_STAGE(PG8_SA(1, 0), cA + kstep, voffA); PG8_STAGE(PG8_SB(1, 1), cB + hstepB + kstep, voffB);
        PG8_WAIT_V(6); PG8_BAR;
    } else {
        PG8_STAGE(PG8_SB(0, 0), cB, voffB); PG8_STAGE(PG8_SA(0, 0), cA, voffA); PG8_STAGE(PG8_SB(0, 1), cB + hstepB, voffB); PG8_STAGE(PG8_SA(0, 1), cA + hstepA, voffA);
        if (wr == 1) PG8_BAR;
        PG8_WAIT_V(4); PG8_BAR;
        PG8_STAGE(PG8_SB(1, 0), cB + kstep, voffB); PG8_STAGE(PG8_SA(1, 0), cA + kstep, voffA); PG8_STAGE(PG8_SB(1, 1), cB + hstepB + kstep, voffB);
        PG8_WAIT_V(6); PG8_BAR;
    }
    for (;;) {
        const bool has_next = S.next(ui + 1, nxt);
        const char* nA = has_next ? (const char*)g.A + (size_t)nxt.pm * tstepA : cA; const char* nB = has_next ? (const char*)g.Bt + (size_t)nxt.pn * tstepB : cB;
        for (int t = 0; t < nt; t += 2) {
            const bool last = (t == nt - 2);
            const char* a1 = cA + (size_t)(t + 1) * kstep;
            const char* a2 = last ? nA : cA + (size_t)(t + 2) * kstep; const char* b2 = last ? nB : cB + (size_t)(t + 2) * kstep;
            const char* a3 = a2 + kstep; const char* b3 = b2 + kstep;
            if (last && has_next) S.a_ready(nxt);
            if constexpr (SP2) {
            PG8_LDB(B0, 0, 0); PG8_LDB(B1, 0, 1); PG8_SCHED; PG8_LDA(At, 0, 0); PG8_STAGE(PG8_SA(1, 1), a1 + hstepA, voffA);
            PG8_WAIT_V(8); PG8_WAIT_L(0); PG8_BAR; PG8_MMA(0, 0, At, B0); PG8_MMA(0, 1, At, B1); PG8_BAR; PG8_SCHED;
            PG8_LDA(At, 0, 1); PG8_STAGE(PG8_SB(0, 0), b2, voffB); PG8_STAGE(PG8_SB(0, 1), b2 + hstepB, voffB); PG8_STAGE(PG8_SA(0, 0), a2, voffA);
            PG8_WAIT_V(8); PG8_WAIT_L(0); PG8_BAR; PG8_MMA(1, 0, At, B0); PG8_MMA(1, 1, At, B1); PG8_BAR; PG8_SCHED;
            PG8_LDB(B0, 1, 0); PG8_LDB(B1, 1, 1); PG8_SCHED; PG8_LDA(At, 1, 0); PG8_STAGE(PG8_SA(0, 1), a2 + hstepA, voffA);
            PG8_WAIT_V(8); PG8_WAIT_L(0); PG8_BAR; PG8_MMA(0, 0, At, B0); PG8_MMA(0, 1, At, B1); PG8_BAR; PG8_SCHED;
            PG8_LDA(At, 1, 1); PG8_STAGE(PG8_SB(1, 0), b3, voffB); PG8_STAGE(PG8_SB(1, 1), b3 + hstepB, voffB); PG8_STAGE(PG8_SA(1, 0), a3, voffA);
            PG8_WAIT_V(8); PG8_WAIT_L(0); PG8_BAR; PG8_MMA(1, 0, At, B0); PG8_MMA(1, 1, At, B1); PG8_BAR; PG8_SCHED;
            } else {
            PG8_LDB(B0, 0, 0); PG8_SCHED; PG8_LDA(At, 0, 0); PG8_STAGE(PG8_SA(1, 1), a1 + hstepA, voffA);
            PG8_WAIT_L(8); PG8_BAR; PG8_WAIT_L(0); PG8_MMA(0, 0, At, B0); PG8_BAR; PG8_SCHED;
            PG8_LDB(B1, 0, 1); PG8_STAGE(PG8_SB(0, 0), b2, voffB);
            PG8_BAR; PG8_WAIT_L(0); PG8_MMA(0, 1, At, B1); PG8_BAR;
            PG8_LDA(At, 0, 1); PG8_STAGE(PG8_SA(0, 0), a2, voffA);
            PG8_BAR; PG8_WAIT_L(0); PG8_MMA(1, 0, At, B0); PG8_BAR; PG8_SCHED;
            PG8_STAGE(PG8_SB(0, 1), b2 + hstepB, voffB);
            PG8_WAIT_V(6); PG8_BAR; PG8_MMA(1, 1, At, B1); PG8_BAR;
            PG8_LDB(B0, 1, 0); PG8_SCHED; PG8_LDA(At, 1, 0); PG8_STAGE(PG8_SA(0, 1), a2 + hstepA, voffA);
            PG8_WAIT_L(8); PG8_BAR; PG8_WAIT_L(0); PG8_MMA(0, 0, At, B0); PG8_BAR; PG8_SCHED;
            PG8_LDB(B1, 1, 1); PG8_STAGE(PG8_SB(1, 0), b3, voffB);
            PG8_BAR; PG8_WAIT_L(0); PG8_MMA(0, 1, At, B1); PG8_BAR;
            PG8_LDA(At, 1, 1); PG8_STAGE(PG8_SA(1, 0), a3, voffA);
            PG8_BAR; PG8_WAIT_L(0); PG8_MMA(1, 0, At, B0); PG8_BAR; PG8_SCHED;
            PG8_STAGE(PG8_SB(1, 1), b3 + hstepB, voffB);
            PG8_WAIT_V(6); PG8_BAR; PG8_MMA(1, 1, At, B1); PG8_BAR;
            }
        }
        if constexpr (ALIGN_EPI) { if (wr == 0) PG8_BAR; }
        if constexpr (!Epi::AFTER_DRAIN) { E(acc, cur, wr, wc, fr, fq); S.done(cur); }
        if (!has_next) break;
#pragma unroll
        for (int a = 0; a < 2; ++a)
#pragma unroll
            for (int b = 0; b < 2; ++b)
#pragma unroll
                for (int m = 0; m < 4; ++m)
#pragma unroll
                    for (int n = 0; n < 2; ++n) acc[a][b][m][n] = (f32x4){0.f, 0.f, 0.f, 0.f};
        cur = nxt; cA = nA; cB = nB; ++ui;
        if constexpr (ALIGN_EPI) { if (wr == 1) PG8_BAR; }
    }
    PG8_WAIT_V(0);
    if constexpr (!ALIGN_EPI) { if (wr == 0) PG8_BAR; }
    PG8_BAR;
    if constexpr (Epi::AFTER_DRAIN) { E.fused(acc, cur, wr, wc, fr, fq, lds, wid, lane); S.done(cur); }
#undef PG8_SA
#undef PG8_SB
#undef PG8_STAGE
#undef PG8_LDA
#undef PG8_LDB
#undef PG8_MMA
#undef PG8_WAIT_V
#undef PG8_WAIT_L
#undef PG8_BAR
#undef PG8_SCHED
}
}
#define LAS __attribute__((address_space(3)))
typedef unsigned short bf16;
typedef short bf16x8 __attribute__((ext_vector_type(8)));
typedef float f32x4 __attribute__((ext_vector_type(4)));
typedef float f32x16 __attribute__((ext_vector_type(16)));
typedef unsigned u32x4 __attribute__((ext_vector_type(4)));
typedef unsigned u32x2 __attribute__((ext_vector_type(2)));
typedef float f32x2_t __attribute__((ext_vector_type(2)));
typedef __bf16 bf16x2_t __attribute__((ext_vector_type(2)));

constexpr int D = 1024, NB = 8, SEQ = 4096, CTXL = 256, FF = 4096;
constexpr int TL = NB * SEQ, TC = NB * CTXL, MT = TL + TC;
constexpr float EPS = 1e-6f, LOG2E = 1.4426950408889634f;
constexpr int NTHREADS = 512, NWAVES = 8;
constexpr size_t MiB = 1u << 20;
constexpr size_t WS_TAB = 0;
constexpr size_t WS_XBAR = 32768;
constexpr size_t WS_XCNT = 49152;
constexpr size_t WS_XBUF = 38 * MiB;
constexpr size_t WS_MODS = 1 * MiB;
constexpr size_t WS_HC = 2 * MiB;
constexpr size_t WS_KR = 10 * MiB;
constexpr size_t WS_W = 14 * MiB;
constexpr size_t WS_WSTRIDE = 26 * MiB;
constexpr size_t WS_U = 66 * MiB;
constexpr size_t WS_Y = 134 * MiB;
constexpr size_t WS_BIG = 202 * MiB;
constexpr size_t WS_YP = 474 * MiB;
constexpr size_t WS_END = 506 * MiB;
constexpr size_t WO_W1 = 0, WO_W2 = 4u << 20, WO_WO = 8u << 20, WO_MIX = 9u << 20;
constexpr int LDS_BYTES = 147456;
constexpr int MODS_PER_LAYER = 9 * 6144;

__device__ __forceinline__ unsigned pk2(float lo, float hi) { f32x2_t v = {lo, hi}; bf16x2_t b = __builtin_convertvector(v, bf16x2_t); return __builtin_bit_cast(unsigned, b); }
__device__ __forceinline__ float bflo(unsigned u) { return __uint_as_float(u << 16); }
__device__ __forceinline__ float bfhi(unsigned u) { return __uint_as_float(u & 0xffff0000u); }
__device__ __forceinline__ float shx(float v, int o, int lane) { return __int_as_float(__builtin_amdgcn_ds_bpermute((lane ^ o) << 2, __float_as_int(v))); }
__device__ __forceinline__ float wave_sum(float v, int lane) {
#pragma unroll
    for (int o = 1; o < 64; o <<= 1) v += shx(v, o, lane);
    return v;
}
__device__ __forceinline__ float xor32(float v, int hh) {
    const unsigned u = __float_as_uint(v);
    auto r = __builtin_amdgcn_permlane32_swap(u, u, false, false);
    return __uint_as_float(hh ? r[0] : r[1]);
}

struct LayerPtrs { const float *ada_w, *ada_b, *norms, *w_a, *w_o, *w1, *w2, *x0, *x1, *w_uq, *w_ukv; };
struct Params { const float *x, *c, *ctx, *c_ctx; float* out; unsigned char* ws; LayerPtrs L[4]; };
#define XB_TMO      128
#define XB_XCNT(j)  (256  + 64 * (j))
#define XB_XSUB(j)  (1280 + 64 * (j))
#define XB_XGEN(j)  (2304 + 64 * (j))
#define XB_TOP      3328
#define XB_TOPGEN   3392
#define XCD_BAR_WORDS 3456
#define XB_SPIN_CAP (1u << 18)

__device__ __forceinline__ unsigned xb_ld(unsigned* p)              { return __hip_atomic_load(p, __ATOMIC_RELAXED, __HIP_MEMORY_SCOPE_AGENT); }
__device__ __forceinline__ unsigned xb_add(unsigned* p, unsigned v) { return __hip_atomic_fetch_add(p, v, __ATOMIC_RELAXED, __HIP_MEMORY_SCOPE_AGENT); }
__device__ __forceinline__ unsigned xb_xcc_id() { return (unsigned)__builtin_amdgcn_s_getreg((3 << 11) | 20) & 0xFu; }
#define XB_SPIN(cond, bar) do { unsigned _sp = 0; while (cond) { __builtin_amdgcn_s_sleep(1); \
    if ((++_sp & 255u) == 0u) { if (xb_ld(&(bar)[XB_TMO])) break; if (_sp > XB_SPIN_CAP) { atomicAdd(&(bar)[XB_TMO], 1u); break; } } } } while (0)

struct XcdBarrier {
    unsigned* bar; unsigned x;
    volatile LAS unsigned* st;
};

__device__ __forceinline__ XcdBarrier xcd_barrier_post(unsigned* bar, volatile LAS unsigned* st) {
    XcdBarrier b; b.bar = bar; b.x = xb_xcc_id(); b.st = st;
    if (threadIdx.x == 0) (void)xb_add(&bar[XB_XCNT(b.x)], 1u);
    return b;
}
__device__ __forceinline__ void xcd_barrier_complete(unsigned* bar, unsigned x, unsigned& nloc, unsigned& nx) {
    const unsigned G = gridDim.x * gridDim.y * gridDim.z;
    unsigned sum, cnt, mine, sp = 0u;
    for (;;) {
        sum = 0u; cnt = 0u; mine = 0u;
#pragma unroll
        for (unsigned j = 0; j < 16; ++j) { const unsigned c = xb_ld(&bar[XB_XCNT(j)]); sum += c; cnt += (c > 0u) ? 1u : 0u; mine = (j == x) ? c : mine; }
        if (sum == G) break;
        __builtin_amdgcn_s_sleep(1);
        if ((++sp & 255u) == 0u) { if (xb_ld(&bar[XB_TMO])) break; if (sp > XB_SPIN_CAP) { atomicAdd(&bar[XB_TMO], 1u); break; } }
    }
    nloc = mine > 0u ? mine : 1u; nx = cnt > 0u ? cnt : 1u;
}

__device__ __forceinline__ void xcd_barrier(const XcdBarrier& b) {
    asm volatile("s_waitcnt vmcnt(0)" ::: "memory");
    __syncthreads();
    if (threadIdx.x == 0) {
        unsigned* bar = b.bar;
        __builtin_amdgcn_s_waitcnt(0);
        unsigned nloc = b.st[0], nx = b.st[1];
        if (nloc == 0u) { xcd_barrier_complete(bar, b.x, nloc, nx); b.st[0] = nloc; b.st[1] = nx; }
        const unsigned old = xb_add(&bar[XB_XSUB(b.x)], 1u);
        const unsigned gen = old / nloc;
        if (old + 1u == (gen + 1u) * nloc) {
            __builtin_amdgcn_fence(__ATOMIC_RELEASE, "agent");
            asm volatile("s_waitcnt vmcnt(0)" ::: "memory");
            const unsigned og = xb_add(&bar[XB_TOP], 1u);
            const unsigned tg = og / nx;
            if (og + 1u == (tg + 1u) * nx) xb_add(&bar[XB_TOPGEN], 1u);
            else XB_SPIN(xb_ld(&bar[XB_TOPGEN]) == tg, bar);
            __builtin_amdgcn_fence(__ATOMIC_ACQUIRE, "agent");
            xb_add(&bar[XB_XGEN(b.x)], 1u);
            asm volatile("s_waitcnt vmcnt(0)" ::: "memory");
        } else {
            XB_SPIN(xb_ld(&bar[XB_XGEN(b.x)]) == gen, bar);
            __builtin_amdgcn_fence(__ATOMIC_ACQUIRE, "agent");
            asm volatile("s_waitcnt vmcnt(0)" ::: "memory");
        }
    }
    __syncthreads();
}
constexpr float AT_THR = 24.f;
#define AT_BAR() do { asm volatile("s_waitcnt lgkmcnt(0)" ::: "memory"); __builtin_amdgcn_s_barrier(); asm volatile("" ::: "memory"); } while (0)
constexpr int AT_KB = 12288, AT_VB = 16384, AT_K0 = 0, AT_V0 = 3 * AT_KB;
template <int DQ, int DV, bool WINDOW, bool GQA = false>
__device__ __forceinline__ void attn_phase(LAS unsigned char* lds, const bf16* __restrict__ Q, int ldq, const bf16* __restrict__ K1, int ldk, int kshift,
                                           const bf16* __restrict__ KR, const bf16* __restrict__ Vt, int vshift, bf16* __restrict__ O, int ldo,
                                           const float* __restrict__ sink, int nunits_lat, int nunits_ctx) {
    constexpr int NKS = DQ / 16, NV = DV / 32, KROWB = DQ * 2, NVL = DV / 64, NKL = (DQ == 64) ? 1 : 2;
    int tid_l = threadIdx.x; asm volatile("" : "+v"(tid_l)); const int tid = tid_l, lane = tid & 63, wave = __builtin_amdgcn_readfirstlane(tid >> 6), r32 = lane & 31, hh = lane >> 5;
    int grp;
    { LAS unsigned* cnt = (LAS unsigned*)(lds + 138240);
      if (tid < 4) cnt[tid] = 0u;
      AT_BAR();
      const unsigned simd = (unsigned)__builtin_amdgcn_s_getreg((1 << 11) | (4 << 6) | 4) & 3u;
      unsigned old = 0u; if (lane == 0) old = __hip_atomic_fetch_add(cnt + simd, 1u, __ATOMIC_RELAXED, __HIP_MEMORY_SCOPE_WORKGROUP);
      grp = (int)(__builtin_amdgcn_readfirstlane(old) & 1u);
      AT_BAR(); }
    const int pk = (r32 & ~0xC) | ((r32 & 4) << 1) | ((r32 & 8) >> 1);
    int koff[NKS];
#pragma unroll
    for (int ks = 0; ks < NKS; ++ks) { const int c = 2 * ks + hh; const int sw = (DQ == 64) ? ((pk >> 1) & 7) : ((pk >> 2) & 3); koff[ks] = pk * KROWB + ((c ^ sw) << 4); }
    int voff[4];
#pragma unroll
    for (int ts = 0; ts < 4; ++ts) voff[ts] = r32 * 128 + (((2 * ts + hh) ^ ((r32 >> 1) & 7)) << 4);
    const int nunits = nunits_lat + nunits_ctx;
    int bid_ = blockIdx.x; asm volatile("" : "+s"(bid_));
    const int gsz_ = gridDim.x; const int vcu_ = (gsz_ % 8 == 0) ? (bid_ % 8) * (gsz_ / 8) + bid_ / 8 : bid_;
    for (int u = vcu_; u < nunits; u += gsz_) {
        const bool isctx = u >= nunits_lat; int b, hq, qrow0;
        if (!GQA) { int qb; if (!isctx) { qb = u & 15; hq = (u >> 4) & 15; b = u >> 8; } else { const int v = u - nunits_lat; hq = v & 15; b = v >> 4; qb = 0; } qrow0 = qb * 256 + wave * 32; }
        else { int qb64, kvh; if (!isctx) { qb64 = u & 63; kvh = (u >> 6) & 3; b = u >> 8; } else { const int v = u - nunits_lat; qb64 = v & 3; kvh = (v >> 2) & 3; b = v >> 4; } hq = kvh * 4 + (wave >> 1); qrow0 = qb64 * 64 + (wave & 1) * 32; }
        const int ublk0 = GQA ? (qrow0 & ~63) : (qrow0 & ~255), ublen = GQA ? 64 : 256;
        const int mqw = (isctx ? TL + b * CTXL : b * SEQ) + qrow0;
        int lt0 = 0, nlt = 0;
        if (!isctx) { if (WINDOW) { const int lo = (ublk0 - 128) < 0 ? 0 : (ublk0 - 128); const int hi = (ublk0 + ublen + 128) > SEQ ? SEQ : (ublk0 + ublen + 128); lt0 = lo >> 6; nlt = (hi - lo) >> 6; } else { lt0 = 0; nlt = 64; } }
        const int nt = 4 + nlt;
        bf16x8 qf[NKS];
        { const bf16* qp = Q + (size_t)(mqw + r32) * ldq + hq * DQ + 8 * hh;
#pragma unroll
          for (int ks = 0; ks < NKS; ++ks) qf[ks] = *(const bf16x8*)(qp + 16 * ks); }
        float m_run, l_run;
        m_run = 0.f; l_run = (sink && hh == 0) ? __builtin_amdgcn_exp2f(sink[hq] * LOG2E) : 0.f;
        f32x16 o[NV];
#pragma unroll
        for (int v = 0; v < NV; ++v)
#pragma unroll
            for (int i = 0; i < 16; ++i) o[v][i] = 0.f;
        const bf16* kbase = K1 + (size_t)(hq >> kshift) * 64;
        const bf16* vbase = Vt + (size_t)((hq >> vshift) * DV) * MT;
        bf16x8 pf[2]; f32x16 s1k; bool pact = true;
#pragma unroll
        for (int i = 0; i < 16; ++i) s1k[i] = 0.f;
#define AT_M0(t) ((t) < 4 ? (TL + b * CTXL + 64 * (t)) : (b * SEQ + (lt0 + (t) - 4) * 64))
#define AT_DMA(src_, dst_) __builtin_amdgcn_global_load_lds((const unsigned*)(src_), (LAS unsigned*)(dst_), 16, 0, 0)
#define AT_LOADK(t, sl) do { const int m0_ = AT_M0(t); LAS unsigned char* kd_ = lds + AT_K0 + (sl) * AT_KB; \
        if (DQ == 64) { const int row = 8 * wave + (lane >> 3), c = (lane & 7) ^ ((row >> 1) & 7); AT_DMA(kbase + (size_t)(m0_ + row) * ldk + 8 * c, kd_ + 1024 * wave); } \
        else { _Pragma("unroll") for (int i = 0; i < 2; ++i) { const int piece = (i == 0) ? wave : (wave < 4 ? wave + 8 : wave); const int o_ = 1024 * piece + 16 * lane; \
                 const int row = o_ / 192, c = ((o_ % 192) >> 4) ^ ((row >> 2) & 3); \
                 const bf16* src = (c < 8) ? kbase + (size_t)(m0_ + row) * ldk + 8 * c : KR + (size_t)(m0_ + row) * 32 + 8 * (c - 8); AT_DMA(src, kd_ + 1024 * piece); } } } while (0)
#define AT_LOADV(t, sl) do { const int m0_ = AT_M0(t); LAS unsigned char* vd_ = lds + AT_V0 + (sl) * AT_VB; \
        _Pragma("unroll") for (int i = 0; i < NVL; ++i) { const int piece = wave + 8 * i; const int row = 8 * piece + (lane >> 3), c16 = (lane & 7) ^ ((row >> 1) & 7); \
            AT_DMA(vbase + (size_t)row * MT + m0_ + 8 * c16, vd_ + 1024 * piece); } } while (0)
#define AT_VMW(n) asm volatile("s_waitcnt vmcnt(%0)" :: "n"(n) : "memory")
#define AT_QKS(te, sl) do { \
        bool active = true; int kpos0 = 0; const bool lat_tile = (te) >= 4; \
        if (lat_tile) kpos0 = (lt0 + (te) - 4) * 64; \
        if (WINDOW && lat_tile) { const int qa = qrow0; active = (kpos0 + 63 >= qa - 128) && (kpos0 <= qa + 31 + 128); } \
        pact = active; \
        if (active) { \
            const LAS unsigned char* kb = lds + AT_K0 + (sl) * AT_KB; \
            f32x16 s0, s1; bf16x8 ka[NKS][2]; \
            _Pragma("unroll") for (int ks = 0; ks < NKS; ++ks) { ka[ks][0] = *(const LAS bf16x8*)(kb + koff[ks]); ka[ks][1] = *(const LAS bf16x8*)(kb + koff[ks] + 32 * KROWB); } \
            __builtin_amdgcn_sched_barrier(0); \
            { f32x16 z_; _Pragma("unroll") for (int i = 0; i < 16; ++i) z_[i] = 0.f; \
              s0 = __builtin_amdgcn_mfma_f32_32x32x16_bf16(ka[0][0], qf[0], z_, 0, 0, 0); s1 = __builtin_amdgcn_mfma_f32_32x32x16_bf16(ka[0][1], qf[0], z_, 0, 0, 0); } \
            _Pragma("unroll") for (int ks = 1; ks < NKS; ++ks) { s0 = __builtin_amdgcn_mfma_f32_32x32x16_bf16(ka[ks][0], qf[ks], s0, 0, 0, 0); s1 = __builtin_amdgcn_mfma_f32_32x32x16_bf16(ka[ks][1], qf[ks], s1, 0, 0, 0); } \
            __builtin_amdgcn_sched_barrier(0); \
            if (__any(m_run != 0.f)) { _Pragma("unroll") for (int i = 0; i < 16; ++i) { s0[i] -= m_run; s1[i] -= m_run; } }     \
            if (WINDOW && lat_tile) { \
                const int qp = qrow0 + r32; float negbig = -1e30f; asm volatile("" : "+v"(negbig)); \
                _Pragma("unroll") for (int i = 0; i < 16; ++i) { const int kr = kpos0 + (i & 3) + 4 * ((i >> 2) & 1) + 8 * hh + 16 * (i >> 3); const int d0 = qp - kr, d1 = qp - (kr + 32); \
                    if (d0 > 128 || d0 < -128) s0[i] = negbig; if (d1 > 128 || d1 < -128) s1[i] = negbig; } \
            } \
            float mx = s0[0]; \
            _Pragma("unroll") for (int i = 1; i < 16; ++i) mx = fmaxf(mx, s0[i]); \
            _Pragma("unroll") for (int i = 0; i < 16; ++i) mx = fmaxf(mx, s1[i]); \
            mx = fmaxf(mx, xor32(mx, hh)); \
            if (__any(mx > AT_THR)) { \
                const float delta = fmaxf(mx, 0.f); const float alpha = __builtin_amdgcn_exp2f(-delta); \
                m_run += delta; l_run *= alpha; \
                _Pragma("unroll") for (int i = 0; i < 16; ++i) { s0[i] -= delta; s1[i] -= delta; } \
                _Pragma("unroll") for (int v = 0; v < NV; ++v) _Pragma("unroll") for (int i = 0; i < 16; ++i) o[v][i] *= alpha; \
            } \
            float ps = 0.f; \
            _Pragma("unroll") for (int i = 0; i < 16; ++i) { s0[i] = __builtin_amdgcn_exp2f(s0[i]); ps += s0[i]; } \
            l_run += ps; \
            { u32x4 w; w.x = pk2(s0[0], s0[1]); w.y = pk2(s0[2], s0[3]); w.z = pk2(s0[4], s0[5]); w.w = pk2(s0[6], s0[7]); pf[0] = __builtin_bit_cast(bf16x8, w); \
              w.x = pk2(s0[8], s0[9]); w.y = pk2(s0[10], s0[11]); w.z = pk2(s0[12], s0[13]); w.w = pk2(s0[14], s0[15]); pf[1] = __builtin_bit_cast(bf16x8, w); } \
            s1k = s1; \
        } } while (0)
#define AT_PV(te, sl) do { if (pact) { \
            const LAS unsigned char* vb = lds + AT_V0 + (sl) * AT_VB; \
            bf16x8 vfa[NV][2]; \
            _Pragma("unroll") for (int v = 0; v < NV; ++v) { vfa[v][0] = *(const LAS bf16x8*)(vb + 32 * 128 * v + voff[0]); vfa[v][1] = *(const LAS bf16x8*)(vb + 32 * 128 * v + voff[1]); } \
            __builtin_amdgcn_sched_barrier(0); \
            __builtin_amdgcn_s_setprio(1); \
            _Pragma("unroll") for (int v = 0; v < NV; ++v) { o[v] = __builtin_amdgcn_mfma_f32_32x32x16_bf16(vfa[v][0], pf[0], o[v], 0, 0, 0); o[v] = __builtin_amdgcn_mfma_f32_32x32x16_bf16(vfa[v][1], pf[1], o[v], 0, 0, 0); } \
            __builtin_amdgcn_s_setprio(0); \
            __builtin_amdgcn_sched_barrier(0); \
            _Pragma("unroll") for (int v = 0; v < NV; ++v) { vfa[v][0] = *(const LAS bf16x8*)(vb + 32 * 128 * v + voff[2]); vfa[v][1] = *(const LAS bf16x8*)(vb + 32 * 128 * v + voff[3]); } \
            bf16x8 pf2, pf3; \
            { float ps = 0.f; \
              _Pragma("unroll") for (int i = 0; i < 16; ++i) { s1k[i] = __builtin_amdgcn_exp2f(s1k[i]); ps += s1k[i]; } \
              l_run += ps; \
              u32x4 w; w.x = pk2(s1k[0], s1k[1]); w.y = pk2(s1k[2], s1k[3]); w.z = pk2(s1k[4], s1k[5]); w.w = pk2(s1k[6], s1k[7]); pf2 = __builtin_bit_cast(bf16x8, w); \
              w.x = pk2(s1k[8], s1k[9]); w.y = pk2(s1k[10], s1k[11]); w.z = pk2(s1k[12], s1k[13]); w.w = pk2(s1k[14], s1k[15]); pf3 = __builtin_bit_cast(bf16x8, w); } \
            __builtin_amdgcn_sched_barrier(0); \
            __builtin_amdgcn_s_setprio(1); \
            _Pragma("unroll") for (int v = 0; v < NV; ++v) { o[v] = __builtin_amdgcn_mfma_f32_32x32x16_bf16(vfa[v][0], pf2, o[v], 0, 0, 0); o[v] = __builtin_amdgcn_mfma_f32_32x32x16_bf16(vfa[v][1], pf3, o[v], 0, 0, 0); } \
            __builtin_amdgcn_s_setprio(0); \
            __builtin_amdgcn_sched_barrier(0); \
        } } while (0)
        int k0_ = 0, k1_ = 1, k2_ = 2;
        AT_LOADK(0, 0); AT_LOADV(0, 0); AT_LOADK(1, 1); AT_LOADV(1, 1); AT_VMW(NKL + NVL); AT_BAR();
        if (grp == 0) {
            for (int t = 0; t < nt; ++t) {
                const bool deep = t + 2 < nt;
                if (deep) { AT_LOADK(t + 2, k2_); AT_LOADV(t + 2, (t + 2) & 3); }
                AT_QKS(t, k0_);
                AT_PV(t, t & 3);
                if (deep) AT_VMW(NKL + NVL); else AT_VMW(0);
                AT_BAR();
                { const int r_ = k0_; k0_ = k1_; k1_ = k2_; k2_ = r_; }
            }
            AT_BAR();
        } else {
            { const bool deep = 2 < nt; if (deep) { AT_LOADK(2, k2_); AT_LOADV(2, 2); }
              AT_QKS(0, k0_);
              if (deep) AT_VMW(NKL + NVL); else AT_VMW(0);
              AT_BAR();
              { const int r_ = k0_; k0_ = k1_; k1_ = k2_; k2_ = r_; } }
            for (int t = 1; t < nt; ++t) {
                const bool deep = t + 2 < nt;
                if (deep) { AT_LOADK(t + 2, k2_); AT_LOADV(t + 2, (t + 2) & 3); }
                AT_PV(t - 1, (t - 1) & 3);
                AT_QKS(t, k0_);
                if (deep) AT_VMW(NKL + NVL); else AT_VMW(0);
                AT_BAR();
                { const int r_ = k0_; k0_ = k1_; k1_ = k2_; k2_ = r_; }
            }
            AT_PV(nt - 1, (nt - 1) & 3);
            AT_BAR();
        }
        const float lt = l_run + xor32(l_run, hh); const float inv = 1.f / lt;
        bf16* op = O + (size_t)(mqw + r32) * ldo + hq * DV + 8 * hh;
#pragma unroll
        for (int v = 0; v < NV; ++v)
#pragma unroll
            for (int g = 0; g < 4; g += 2) {
                unsigned ax = pk2(o[v][4 * g] * inv, o[v][4 * g + 1] * inv), ay = pk2(o[v][4 * g + 2] * inv, o[v][4 * g + 3] * inv);
                unsigned bx = pk2(o[v][4 * g + 4] * inv, o[v][4 * g + 5] * inv), by = pk2(o[v][4 * g + 6] * inv, o[v][4 * g + 7] * inv);
                auto r0 = __builtin_amdgcn_permlane32_swap(ax, bx, false, false); auto r1 = __builtin_amdgcn_permlane32_swap(ay, by, false, false);
                u32x4 w; w.x = r0[0]; w.y = r1[0]; w.z = r0[1]; w.w = r1[1];
                *(u32x4*)(op + 32 * v + 8 * g) = w; }
#undef AT_M0
#undef AT_LOADK
#undef AT_LOADV
#undef AT_DMA
#undef AT_VMW
#undef AT_QKS
#undef AT_PV
    }
}
__device__ __forceinline__ void post_pass(int gw, int ngw, int lane, const bf16* __restrict__ Y, const float* __restrict__ gY, const float* __restrict__ modsY, int gate_idx,
                                          const float* hin_lat, const float* hin_ctx, float* hout_lat, float* hout_ctx,
                                          bf16* __restrict__ U, const float* __restrict__ gU, const float* __restrict__ modsU, int shift_idx, int scale_idx, int nrows,
                                          const bf16* __restrict__ Yp = nullptr, int nparts = 0, int row_begin = 0) {
    float eps_ = EPS; asm volatile("" : "+v"(eps_));
    for (int r = row_begin + gw; r < nrows; r += ngw) {
        const bool lat = r < TL; const int mb = lat ? (r >> 12) : 8;
        const float* hi_ = lat ? hin_lat + (size_t)r * D : hin_ctx + (size_t)(r - TL) * D;
        f32x4 h[4];
#pragma unroll
        for (int j = 0; j < 4; ++j) h[j] = *(const f32x4*)(hi_ + 256 * j + 4 * lane);
        if (Y) {
            f32x4 y[4]; float ss = 0.f;
            if (Yp && !lat) {
#pragma unroll
                for (int j = 0; j < 4; ++j) y[j] = (f32x4){0.f, 0.f, 0.f, 0.f};
                for (int k = 0; k < nparts; ++k) { const bf16* yr = Yp + ((size_t)k * TC + (r - TL)) * D;
#pragma unroll
                    for (int j = 0; j < 4; ++j) { const u32x2 w = *(const u32x2*)(yr + 256 * j + 4 * lane); y[j] = y[j] + (f32x4){bflo(w.x), bfhi(w.x), bflo(w.y), bfhi(w.y)}; } }
            } else { const bf16* yr = Y + (size_t)r * D;
#pragma unroll
                for (int j = 0; j < 4; ++j) { const u32x2 w = *(const u32x2*)(yr + 256 * j + 4 * lane); y[j] = (f32x4){bflo(w.x), bfhi(w.x), bflo(w.y), bfhi(w.y)}; } }
#pragma unroll
            for (int j = 0; j < 4; ++j) ss += (y[j][0] * y[j][0] + y[j][1] * y[j][1]) + (y[j][2] * y[j][2] + y[j][3] * y[j][3]);
            const float rs = rsqrtf(wave_sum(ss, lane) * (1.f / D) + eps_);
            const float* gt = modsY + (size_t)mb * 6144 + gate_idx * D;
            float* ho = lat ? hout_lat + (size_t)r * D : hout_ctx + (size_t)(r - TL) * D;
#pragma unroll
            for (int j = 0; j < 4; ++j) { const f32x4 g = *(const f32x4*)(gY + 256 * j + 4 * lane); const f32x4 ga = *(const f32x4*)(gt + 256 * j + 4 * lane);
                h[j] = h[j] + ga * (y[j] * rs * g); *(f32x4*)(ho + 256 * j + 4 * lane) = h[j]; }
        }
        if (U) {
            float ss = 0.f;
#pragma unroll
            for (int j = 0; j < 4; ++j) ss += (h[j][0] * h[j][0] + h[j][1] * h[j][1]) + (h[j][2] * h[j][2] + h[j][3] * h[j][3]);
            const float rs = rsqrtf(wave_sum(ss, lane) * (1.f / D) + eps_);
            const float* sh = modsU + (size_t)mb * 6144 + shift_idx * D; const float* sc = modsU + (size_t)mb * 6144 + scale_idx * D;
            bf16* ur = U + (size_t)r * D;
#pragma unroll
            for (int j = 0; j < 4; ++j) { const f32x4 g = *(const f32x4*)(gU + 256 * j + 4 * lane); const f32x4 s1 = *(const f32x4*)(sc + 256 * j + 4 * lane); const f32x4 s0 = *(const f32x4*)(sh + 256 * j + 4 * lane);
                const f32x4 v = (h[j] * rs * g) * (s1 + 1.f) + s0; u32x2 w; w.x = pk2(v[0], v[1]); w.y = pk2(v[2], v[3]); *(u32x2*)(ur + 256 * j + 4 * lane) = w; }
        }
    }
}
__device__ __forceinline__ void diff_combine(int gw, int ngw, int lane, const bf16* __restrict__ OB, bf16* __restrict__ ATT, const float* __restrict__ lam, const float* __restrict__ subln, float lam_init) {
    const float p1 = wave_sum(lam[lane] * lam[64 + lane], lane), p2 = wave_sum(lam[128 + lane] * lam[192 + lane], lane);
    const float lam_full = expf(p1) - expf(p2) + lam_init;
    const int hd = lane >> 3, j0 = (lane & 7) * 16;
    float g[16];
#pragma unroll
    for (int e = 0; e < 16; ++e) g[e] = subln[j0 + e] * (1.f - lam_init);
    for (int r = gw; r < MT; r += ngw) {
        const bf16* p = OB + (size_t)r * 2048 + hd * 256 + j0;
        const u32x4 a0 = *(const u32x4*)p, a1 = *(const u32x4*)(p + 8), b0 = *(const u32x4*)(p + 128), b1 = *(const u32x4*)(p + 136);
        const unsigned aw[8] = {a0.x, a0.y, a0.z, a0.w, a1.x, a1.y, a1.z, a1.w}, bw[8] = {b0.x, b0.y, b0.z, b0.w, b1.x, b1.y, b1.z, b1.w};
        float o[16]; float ss = 0.f;
#pragma unroll
        for (int e = 0; e < 8; ++e) { o[2 * e] = bflo(aw[e]) - lam_full * bflo(bw[e]); o[2 * e + 1] = bfhi(aw[e]) - lam_full * bfhi(bw[e]); ss += o[2 * e] * o[2 * e] + o[2 * e + 1] * o[2 * e + 1]; }
        ss += shx(ss, 1, lane); ss += shx(ss, 2, lane); ss += shx(ss, 4, lane);
        const float rs = rsqrtf(ss * (1.f / 128.f) + EPS);
        u32x4 w0, w1;
        w0.x = pk2(o[0] * rs * g[0], o[1] * rs * g[1]); w0.y = pk2(o[2] * rs * g[2], o[3] * rs * g[3]); w0.z = pk2(o[4] * rs * g[4], o[5] * rs * g[5]); w0.w = pk2(o[6] * rs * g[6], o[7] * rs * g[7]);
        w1.x = pk2(o[8] * rs * g[8], o[9] * rs * g[9]); w1.y = pk2(o[10] * rs * g[10], o[11] * rs * g[11]); w1.z = pk2(o[12] * rs * g[12], o[13] * rs * g[13]); w1.w = pk2(o[14] * rs * g[14], o[15] * rs * g[15]);
        bf16* q = ATT + (size_t)r * D + hd * 128 + j0; *(u32x4*)q = w0; *(u32x4*)(q + 8) = w1;
    }
}
__device__ __forceinline__ void mla_norm(int gw, int ngw, int lane, bf16* __restrict__ CQ, bf16* __restrict__ KR, const float* __restrict__ qn, const float* __restrict__ kvn, const float* __restrict__ tab32) {
    for (int r = gw; r < MT; r += ngw) {
        bf16* row = CQ + (size_t)r * 768;
        unsigned* cq = (unsigned*)(row + 6 * lane); unsigned a0 = cq[0], a1 = cq[1], a2 = cq[2];
        float x[6] = {bflo(a0), bfhi(a0), bflo(a1), bfhi(a1), bflo(a2), bfhi(a2)}; float ss = 0.f;
#pragma unroll
        for (int e = 0; e < 6; ++e) ss += x[e] * x[e];
        float rs = rsqrtf(wave_sum(ss, lane) * (1.f / 384.f) + EPS);
#pragma unroll
        for (int e = 0; e < 6; ++e) x[e] = x[e] * rs * qn[6 * lane + e];
        cq[0] = pk2(x[0], x[1]); cq[1] = pk2(x[2], x[3]); cq[2] = pk2(x[4], x[5]);
        u32x2* ck = (u32x2*)(row + 384 + 4 * lane); u32x2 b = *ck; float y[4] = {bflo(b.x), bfhi(b.x), bflo(b.y), bfhi(b.y)};
        ss = y[0] * y[0] + y[1] * y[1] + y[2] * y[2] + y[3] * y[3];
        rs = rsqrtf(wave_sum(ss, lane) * (1.f / 256.f) + EPS);
#pragma unroll
        for (int e = 0; e < 4; ++e) y[e] = y[e] * rs * kvn[4 * lane + e];
        b.x = pk2(y[0], y[1]); b.y = pk2(y[2], y[3]); *ck = b;
        const int l = lane & 31; const float v = __uint_as_float((unsigned)row[640 + l] << 16);
        const float p = shx(v, 8, lane);
        float outv = v;
        if (r < TL) { const int s = r & 4095; const int pos = (l & 16) ? (s & 63) : (s >> 6); const float cs = tab32[(pos * 8 + (l & 7)) * 2], sn = tab32[(pos * 8 + (l & 7)) * 2 + 1];
            outv = (l & 8) ? v * cs + p * sn : v * cs - p * sn; }
        const float nb = shx(outv, 1, lane);
        if (lane < 32 && !(lane & 1)) *(unsigned*)(KR + (size_t)r * 32 + lane) = pk2(outv, nb);
    }
}
__device__ __forceinline__ void conv_tile(LAS float* scr, const float* __restrict__ src, int N, int k0, int c0, bf16* __restrict__ dst, int ldd, int drow0, int tid) {
    const int nn = tid & 63, kq = tid >> 6;
#pragma unroll
    for (int i = 0; i < 8; ++i) { const int kk = kq + 8 * i; scr[kk * 65 + nn] = (c0 + nn < N) ? src[(size_t)(k0 + kk) * N + c0 + nn] : 0.f; }
    __syncthreads();
    const int n = tid >> 3, kc = tid & 7; const LAS float* s = scr + (8 * kc) * 65 + n;
    u32x4 o; o.x = pk2(s[0], s[65]); o.y = pk2(s[2 * 65], s[3 * 65]); o.z = pk2(s[4 * 65], s[5 * 65]); o.w = pk2(s[6 * 65], s[7 * 65]);
    *(u32x4*)(dst + (size_t)(drow0 + n) * ldd + k0 + 8 * kc) = o;
    __syncthreads();
}
__device__ __forceinline__ void conv_layer(LAS unsigned char* lds, const LayerPtrs& L, int kind, bf16* W, int tid) {
    LAS float* scr = (LAS float*)lds;
    bf16* mix = W + WO_MIX;
    const int n_w1 = 16 * 64, n_w2 = 64 * 16, n_wo = 16 * 16;
    int n_a, n_uq = 0, n_ukv = 0;
    if (kind == 0) n_a = 16 * 24; else if (kind == 1) n_a = 16 * 48; else { n_a = 16 * 12; n_uq = 6 * 24; n_ukv = 4 * 32; }
    const int total = n_w1 + n_w2 + n_wo + n_a + n_uq + n_ukv;
    const int nn = tid & 63, kq = tid >> 6;
#define CJ_DECODE(r_in, SRC, NN, K0, C0, DST, LDD, DR0) do { int r = (r_in); \
        if (r < n_w1) { SRC = L.w1; NN = FF; K0 = (r / 64) * 64; C0 = (r % 64) * 64; DST = W + WO_W1; LDD = D; DR0 = (r % 64) * 64; } \
        else if ((r -= n_w1) < n_w2) { SRC = L.w2; NN = D; K0 = (r / 16) * 64; C0 = (r % 16) * 64; DST = W + WO_W2; LDD = FF; DR0 = (r % 16) * 64; } \
        else if ((r -= n_w2) < n_wo) { SRC = L.w_o; NN = D; K0 = (r / 16) * 64; C0 = (r % 16) * 64; DST = W + WO_WO; LDD = D; DR0 = (r % 16) * 64; } \
        else if ((r -= n_wo) < n_a) { SRC = L.w_a; LDD = D; \
            if (kind == 0) { const int kt = r / 24, tn = r % 24; NN = 1536; K0 = kt * 64; C0 = tn * 64; DST = tn < 20 ? mix : mix + (size_t)1280 * D; DR0 = tn < 20 ? tn * 64 : (tn - 20) * 64; } \
            else if (kind == 1) { const int kt = r / 48, tn = r % 48; NN = 3072; K0 = kt * 64; C0 = tn * 64; DST = tn < 32 ? mix : mix + (size_t)2048 * D; DR0 = tn < 32 ? tn * 64 : (tn - 32) * 64; } \
            else { const int kt = r / 12, tn = r % 12; NN = 672; K0 = kt * 64; C0 = tn * 64; DST = mix; DR0 = tn * 64; } } \
        else if ((r -= n_a) < n_uq) { const int kt = r / 24, tn = r % 24; SRC = L.w_uq; NN = 1536; K0 = kt * 64; C0 = tn * 64; DST = mix + (size_t)768 * D; LDD = 384; DR0 = tn * 64; } \
        else { r -= n_uq; const int kt = r / 32, tn = r % 32; SRC = L.w_ukv; NN = 2048; K0 = kt * 64; C0 = tn * 64; \
               DST = mix + (size_t)768 * D + (size_t)1536 * 384 + ((tn & 1) ? (size_t)1024 * 256 : 0); LDD = 256; DR0 = (tn >> 1) * 64; } } while (0)
#define CJ_LOAD(V, SRC, NN, K0, C0) do { _Pragma("unroll") for (int i = 0; i < 8; ++i) V[i] = ((C0) + nn < (NN)) ? (SRC)[(size_t)((K0) + kq + 8 * i) * (NN) + (C0) + nn] : 0.f; } while (0)
    int bid_ = blockIdx.x; asm volatile("" : "+s"(bid_));
    const int gsz = gridDim.x;
    int it = bid_;
    const float* src = nullptr; int N = 0, k0 = 0, c0 = 0, ldd = 0, drow0 = 0; bf16* dst = nullptr;
    float v[8];
    if (it < total) { CJ_DECODE(it, src, N, k0, c0, dst, ldd, drow0); CJ_LOAD(v, src, N, k0, c0); }
    while (it < total) {
#pragma unroll
        for (int i = 0; i < 8; ++i) scr[(kq + 8 * i) * 65 + nn] = v[i];
        const int itn = it + gsz;
        const float* srcn = nullptr; int Nn = 0, k0n = 0, c0n = 0, lddn = 0, drow0n = 0; bf16* dstn = nullptr;
        if (itn < total) { CJ_DECODE(itn, srcn, Nn, k0n, c0n, dstn, lddn, drow0n); CJ_LOAD(v, srcn, Nn, k0n, c0n); }
        __syncthreads();
        { const int n = tid >> 3, kc = tid & 7; const LAS float* sp = scr + (8 * kc) * 65 + n;
          u32x4 o; o.x = pk2(sp[0], sp[65]); o.y = pk2(sp[2 * 65], sp[3 * 65]); o.z = pk2(sp[4 * 65], sp[5 * 65]); o.w = pk2(sp[6 * 65], sp[7 * 65]);
          *(u32x4*)(dst + (size_t)(drow0 + n) * ldd + k0 + 8 * kc) = o; }
        __syncthreads();
        it = itn; src = srcn; N = Nn; k0 = k0n; c0 = c0n; dst = dstn; ldd = lddn; drow0 = drow0n;
    }
#undef CJ_DECODE
#undef CJ_LOAD
}
__device__ __forceinline__ void mods_phase(LAS unsigned char* lds, const Params& p, float* mods, int tid) {
    LAS float* sc = (LAS float*)lds;
    LAS float* red = (LAS float*)(lds + 9 * 1024 * 4);
    for (int idx = tid; idx < 9 * 1024; idx += NTHREADS) { const int bb = idx >> 10, k = idx & 1023; const float v = bb < 8 ? p.c[bb * 1024 + k] : p.c_ctx[k]; sc[idx] = v / (1.f + __expf(-v)); }
    __syncthreads();
    const int col = tid & 63, kg = tid >> 6;
    int bid_ = blockIdx.x; asm volatile("" : "+s"(bid_));
    for (int it = bid_; it < 4 * 96; it += gridDim.x) {
        const int l = it / 96, n0 = (it % 96) * 64;
        const float* aw = p.L[l].ada_w; const float* ab = p.L[l].ada_b;
        float acc[9];
#pragma unroll
        for (int bb = 0; bb < 9; ++bb) acc[bb] = 0.f;
        const float* wp = aw + (size_t)(kg * 128) * 6144 + n0 + col;
#pragma unroll 32
        for (int k = 0; k < 128; ++k) { const float w = wp[(size_t)k * 6144];
#pragma unroll
            for (int bb = 0; bb < 9; ++bb) acc[bb] += sc[bb * 1024 + kg * 128 + k] * w; }
#pragma unroll
        for (int bb = 0; bb < 9; ++bb) red[(kg * 9 + bb) * 64 + col] = acc[bb];
        __syncthreads();
        for (int o = tid; o < 576; o += NTHREADS) { const int bb = o >> 6, c = o & 63; float s = 0.f;
#pragma unroll
            for (int g = 0; g < 8; ++g) s += red[(g * 9 + bb) * 64 + c];
            mods[(size_t)l * MODS_PER_LAYER + bb * 6144 + n0 + c] = s + ab[n0 + c]; }
        __syncthreads();
    }
}
__device__ __forceinline__ void tables_phase(float* tab64, float* tab32) {
    const int g = blockIdx.x * NTHREADS + threadIdx.x;
    if (g < 1024) { const int pos = g >> 4, i = g & 15; const float inv = powf(10000.f, -(float)i / 16.f); const float a = (float)pos * inv; tab64[2 * g] = cosf(a); tab64[2 * g + 1] = sinf(a); }
    else if (g < 1536) { const int h = g - 1024; const int pos = h >> 3, i = h & 7; const float inv = powf(10000.f, -(float)i / 8.f); const float a = (float)pos * inv; tab32[2 * h] = cosf(a); tab32[2 * h + 1] = sinf(a); }
}

constexpr int REP_A = 1, REP_B = 1, REP_C = 1, REP_MLP = 1, REP_SYNC = 0, REP_P1 = 1, REP_P0 = 1;
template <class Epi> __device__ __forceinline__ void run_gemm(LAS unsigned char* lds, const bf16* A, int lda, const bf16* Bt, int ldb, int M, int N, int K, const Epi& E, int cidx = -1) {
    pg8::Gemm g{A, Bt, M, N, K, lda, ldb}; int bid_ = blockIdx.x, gd_ = gridDim.x; asm volatile("" : "+s"(bid_), "+s"(gd_)); pg8::StaticOrder S; S.init(M, N, gd_, cidx >= 0 ? cidx : bid_);
    pg8::gemm_phase<Epi, pg8::StaticOrder, true, false>((PG8_LAS unsigned char*)lds, g, S, E);
}

__global__ void __launch_bounds__(NTHREADS, 2) fwd_megakernel(Params p) {
    extern __shared__ __attribute__((aligned(16))) unsigned char lds_raw[];
    LAS unsigned char* lds = (LAS unsigned char*)lds_raw;
    cg::grid_group grid = cg::this_grid();
    volatile LAS unsigned* xb_st = (volatile LAS unsigned*)(lds + 139264);
    if (threadIdx.x == 0) { xb_st[0] = 0u; xb_st[1] = 0u; }
    __syncthreads();
    (void)xcd_barrier_post((unsigned*)(p.ws + WS_XBAR), xb_st);
#define GSYNC() do { size_t zb_ = 0; asm volatile("" : "+s"(zb_)); XcdBarrier xb_; xb_.bar = (unsigned*)(p.ws + WS_XBAR + zb_); xb_.x = xb_xcc_id(); xb_.st = (volatile LAS unsigned*)(lds + 139264); xcd_barrier(xb_); } while (0)
    int tid, lane, wave, gw; const int ngw = gridDim.x * NWAVES;
#define FRESH() do { int t_ = threadIdx.x; asm volatile("" : "+v"(t_)); tid = t_; lane = tid & 63; wave = __builtin_amdgcn_readfirstlane(tid >> 6); int b_ = blockIdx.x; asm volatile("" : "+s"(b_)); gw = b_ * NWAVES + wave; } while (0)
#define DERIVE() size_t z_ = 0; asm volatile("" : "+s"(z_)); unsigned char* ws = p.ws + z_; \
    float* tab64 = (float*)(ws + WS_TAB); float* tab32 = (float*)(ws + WS_TAB + 8192); float* mods = (float*)(ws + WS_MODS); float* HC = (float*)(ws + WS_HC); \
    bf16* KR = (bf16*)(ws + WS_KR); bf16* U = (bf16*)(ws + WS_U); bf16* Y = (bf16*)(ws + WS_Y); bf16* BIG = (bf16*)(ws + WS_BIG); \
    (void)tab64; (void)tab32; (void)mods; (void)HC; (void)KR; (void)U; (void)Y; (void)BIG
#define DERIVE_L() DERIVE(); bf16* W = (bf16*)(ws + WS_W + (size_t)(l & 1) * WS_WSTRIDE); bf16* mix = W + WO_MIX; const float* modsl = mods + (size_t)l * MODS_PER_LAYER; (void)mix; (void)modsl
    FRESH();
    for (int rep = 0; rep < REP_P0; ++rep) { DERIVE();
      tables_phase(tab64, tab32);
      mods_phase(lds, p, mods, tid);
      conv_layer(lds, p.L[0], 0, (bf16*)(ws + WS_W), tid); }
    if (p.ws == nullptr) grid.sync();
    GSYNC(); FRESH();
    for (int rep = 0; rep < REP_SYNC; ++rep) GSYNC();
    for (int rep = 0; rep < REP_P1; ++rep) { DERIVE(); post_pass(gw, ngw, lane, nullptr, nullptr, nullptr, 0, p.x, p.ctx, nullptr, nullptr, U, p.L[0].norms, mods, 0, 1, MT); }
    GSYNC(); FRESH();

#pragma unroll 1
    for (int l = 0; l < 4; ++l) {
        const int kind = l % 3;
        if (kind == 0) {
            { DERIVE_L(); bf16* Qb = BIG; bf16* Kb = BIG + (size_t)MT * 1024; bf16* Vt = Kb + (size_t)MT * 256;
              { pg8::EpiRope<0> E{Qb, 1024, 1024, Kb, 256, 0.125f * LOG2E, tab64, TL}; run_gemm(lds, U, D, mix, D, MT, 1280, D, E); }
              { pg8::EpiStore E{Vt, MT, 0, nullptr, 0, 0}; run_gemm(lds, mix + (size_t)1280 * D, D, U, D, 256, MT, D, E); } }
            GSYNC(); FRESH();
            { DERIVE_L(); bf16* Qb = BIG; bf16* Kb = BIG + (size_t)MT * 1024; bf16* Vt = Kb + (size_t)MT * 256;
              for (int rep = 0; rep < REP_A; ++rep) attn_phase<64, 64, true, true>(lds, Qb, 1024, Kb, 256, 2, nullptr, Vt, 2, U, 1024, p.L[l].x0, 2048, 128); }
            GSYNC(); FRESH();
        } else if (kind == 1) {
            { DERIVE_L(); bf16* Qb = BIG; bf16* Kb = BIG + (size_t)MT * 1024; bf16* Vt = Kb + (size_t)MT * 1024;
              { pg8::EpiRope<0> E{Qb, 1024, 1024, Kb, 1024, 0.125f * LOG2E, tab64, TL}; run_gemm(lds, U, D, mix, D, MT, 2048, D, E); }
              { pg8::EpiStore E{Vt, MT, 0, nullptr, 0, 0}; run_gemm(lds, mix + (size_t)2048 * D, D, U, D, 1024, MT, D, E, (int)((blockIdx.x + 256 - 64) & 255)); } }
            GSYNC(); FRESH();
            { DERIVE_L(); bf16* Qb = BIG; bf16* Kb = BIG + (size_t)MT * 1024; bf16* Vt = Kb + (size_t)MT * 1024;
              for (int rep = 0; rep < REP_B; ++rep) attn_phase<64, 128, false>(lds, Qb, 1024, Kb, 1024, 0, nullptr, Vt, 1, U  , 2048, nullptr, 2048, 128); }
            GSYNC(); FRESH();
            { DERIVE_L(); diff_combine(gw, ngw, lane, U, BIG, p.L[l].x0, p.L[l].x1, 0.8f - 0.6f * 0.7408182206817179f); }
            GSYNC(); FRESH();
        } else {
            { DERIVE_L(); pg8::EpiStore E{Y, 768, 0, nullptr, 0, 0}; run_gemm(lds, U, D, mix, D, MT, 768, D, E); }
            GSYNC(); FRESH();
            { DERIVE_L(); mla_norm(gw, ngw, lane, Y, KR, p.L[l].x0, p.L[l].x1, tab32); }
            GSYNC(); FRESH();
            { DERIVE_L(); bf16* CQ = Y; bf16* Qb = BIG; bf16* Kn = BIG + (size_t)MT * 1536; bf16* Vt = Kn + (size_t)MT * 1024;
              const bf16* Wuq = mix + (size_t)768 * D; const bf16* Wkn = Wuq + (size_t)1536 * 384; const bf16* Wv = Wkn + (size_t)1024 * 256;
              { pg8::EpiRope<1> E{Qb, 1536, 0, nullptr, 0, 0.10206207261596575f * LOG2E, tab32, TL}; run_gemm(lds, CQ, 768, Wuq, 384, MT, 1536, 384, E); }
              { pg8::EpiStore E{Kn, 1024, 0, nullptr, 0, 0}; run_gemm(lds, CQ + 384, 768, Wkn, 256, MT, 1024, 256, E, (int)((blockIdx.x + 256 - 48) & 255)); }
              { pg8::EpiStore E{Vt, MT, 0, nullptr, 0, 0}; run_gemm(lds, Wv, 256, CQ + 384, 768, 1024, MT, 256, E, (int)((blockIdx.x + 256 - 80) & 255)); } }
            GSYNC(); FRESH();
            { DERIVE_L(); bf16* Qb = BIG; bf16* Kn = BIG + (size_t)MT * 1536; bf16* Vt = Kn + (size_t)MT * 1024;
              for (int rep = 0; rep < REP_C; ++rep) attn_phase<96, 64, false>(lds, Qb, 1536, Kn, 1024, 0, KR, Vt, 0, U, 1024, nullptr, 2048, 128); }
            GSYNC(); FRESH();
        }
        { DERIVE_L(); const bf16* attn_out = (kind == 1) ? BIG : U; const float* nr = p.L[l].norms;
          { pg8::EpiFuse E{(l == 0) ? p.x : p.out, p.out, U, nr + D, modsl + 2 * D, nr + 2 * D, modsl + 4 * D, modsl + 3 * D,
                           (float*)(ws + WS_XBUF), (unsigned*)(ws + WS_XCNT), 16u * (unsigned)(2 * (2 * l) + 1), (PG8_LAS unsigned char*)(lds + 131072), EPS};
            run_gemm(lds, attn_out, D, W + WO_WO, D, TL, D, D, E); }
          if (l < 3) {
              int kc = blockIdx.x >> 5; asm volatile("" : "+s"(kc)); const int kcc = kc < 4 ? kc : 0;
              pg8::EpiStore E{(bf16*)(ws + WS_YP) + (size_t)kcc * TC * D, D, 0, nullptr, 0, 0};
              run_gemm(lds, attn_out + (size_t)TL * D + kcc * 256, D, W + WO_WO + kcc * 256, D, TC, D, 256, E, kc < 4 ? (int)(blockIdx.x & 31) : (1 << 20)); } }
        GSYNC(); FRESH();
        if (l < 3) {
            { DERIVE_L(); const float* nr = p.L[l].norms;
              post_pass(gw, ngw, lane, Y, nr + D, modsl, 2, p.out, (l == 0) ? p.ctx : HC, p.out, HC, U, nr + 2 * D, modsl, 3, 4, MT, (const bf16*)(ws + WS_YP), 4, TL); }
            GSYNC(); FRESH();
        }
        { DERIVE_L(); pg8::EpiStore E{BIG, FF, 0, nullptr, 0, 1}; run_gemm(lds, U, D, W + WO_W1, D, l < 3 ? MT : TL, FF, D, E); }
        GSYNC(); FRESH();
        { DERIVE_L(); const int ln_ = l < 3 ? l + 1 : l;
          { pg8::EpiFuse E{p.out, p.out, l < 3 ? U : nullptr, p.L[l].norms + 3 * D, modsl + 5 * D, p.L[ln_].norms, modsl + MODS_PER_LAYER + 1 * D, modsl + MODS_PER_LAYER,
                           (float*)(ws + WS_XBUF), (unsigned*)(ws + WS_XCNT), 16u * (unsigned)(2 * (2 * l + 1) + 1), (PG8_LAS unsigned char*)(lds + 131072), EPS};
            run_gemm(lds, BIG, FF, W + WO_W2, FF, TL, D, FF, E); }
          if (l < 3) {
              int kc = blockIdx.x >> 5; asm volatile("" : "+s"(kc)); const int kcc = kc & 7;
              pg8::EpiStore E{(bf16*)(ws + WS_YP) + (size_t)kcc * TC * D, D, 0, nullptr, 0, 0};
              run_gemm(lds, BIG + (size_t)TL * FF + kcc * 512, FF, W + WO_W2 + kcc * 512, FF, TC, D, 512, E, (int)(blockIdx.x & 31)); } }
        if (l < 3) {
            GSYNC(); FRESH();
            { DERIVE_L(); post_pass(gw, ngw, lane, Y, p.L[l].norms + 3 * D, modsl, 5, p.out, HC, p.out, HC, U, p.L[l + 1].norms, modsl + MODS_PER_LAYER, 0, 1, MT, (const bf16*)(ws + WS_YP), 8, TL);
              conv_layer(lds, p.L[l + 1], (l + 1) % 3, (bf16*)(ws + WS_W + (size_t)((l + 1) & 1) * WS_WSTRIDE), tid); }
            GSYNC(); FRESH();
        }
    }
}

extern "C" void kernel_launch(void* const* d_in, const int* in_sizes, int n_in, void* d_out, int out_size, void* d_ws, size_t ws_size, hipStream_t stream) {
    static int grid = 0;
    if (grid == 0) {
        if (n_in != 40 || ws_size < WS_END || out_size != TL * D) { fprintf(stderr, "kernel_launch: unexpected shapes n_in %d ws %zu out %d\n", n_in, ws_size, out_size); grid = -1; return; }
        int dev = 0, cus = 0, per_cu = 0;
        hipGetDevice(&dev); hipDeviceGetAttribute(&cus, hipDeviceAttributeMultiprocessorCount, dev);
        if (hipFuncSetAttribute((const void*)fwd_megakernel, hipFuncAttributeMaxDynamicSharedMemorySize, LDS_BYTES) != hipSuccess) { fprintf(stderr, "hipFuncSetAttribute failed\n"); grid = -1; return; }
        if (hipOccupancyMaxActiveBlocksPerMultiprocessor(&per_cu, (const void*)fwd_megakernel, NTHREADS, LDS_BYTES) != hipSuccess || per_cu < 1) { fprintf(stderr, "occupancy query: %d\n", per_cu); per_cu = 1; }
        (void)hipGetLastError();
        grid = cus * 1;
    }
    if (grid < 0) return;
    Params p{};
    p.x = (const float*)d_in[0]; p.c = (const float*)d_in[1]; p.ctx = (const float*)d_in[2]; p.c_ctx = (const float*)d_in[3];
    p.out = (float*)d_out; p.ws = (unsigned char*)d_ws;
    auto F = [&](int i) { return (const float*)d_in[i]; };
    p.L[0] = LayerPtrs{F(4), F(5), F(6), F(7), F(9), F(10), F(11), F(8), nullptr, nullptr, nullptr};
    p.L[1] = LayerPtrs{F(12), F(13), F(14), F(15), F(18), F(19), F(20), F(16), F(17), nullptr, nullptr};
    p.L[2] = LayerPtrs{F(21), F(22), F(23), F(24), F(29), F(30), F(31), F(25), F(26), F(27), F(28)};
    p.L[3] = LayerPtrs{F(32), F(33), F(34), F(35), F(37), F(38), F(39), F(36), nullptr, nullptr, nullptr};
    (void)hipMemsetAsync((char*)d_ws + WS_XBAR, 0, WS_XCNT + 128 * 256 - WS_XBAR, stream);
    void* args[] = {&p};
    hipError_t e = hipLaunchCooperativeKernel((const void*)fwd_megakernel, dim3(grid), dim3(NTHREADS), args, LDS_BYTES, stream);
    if (e != hipSuccess) fprintf(stderr, "cooperative launch failed: %s (grid %d)\n", hipGetErrorString(e), grid);
}
```

```cpp
#include <hip/hip_runtime.h>
#include <hip/hip_cooperative_groups.h>
#include <cstdio>
#include <cstdint>
namespace cg = cooperative_groups;
namespace pg8 {
#define PG8_LAS __attribute__((address_space(3)))
typedef unsigned short bf16_t;
typedef short bf16x8 __attribute__((ext_vector_type(8)));
typedef float f32x4 __attribute__((ext_vector_type(4)));
typedef unsigned u32x4 __attribute__((ext_vector_type(4)));
constexpr int BM = 256, BK = 64, HALF = 128, HTB = HALF * BK * 2  , STAGE_BYTES = 8 * HTB, NXCD = 8, WGM = 8;

__host__ __device__ __forceinline__ int lds_byte(int r, int c) { const int st = (r >> 4) * 2 + (c >> 5), rr = r & 15, cc = c & 31, ob = rr * 64 + cc * 2; return st * 1024 + (ob ^ (((ob >> 9) & 1) << 5)); }
__host__ __device__ __forceinline__ void stage_rc(int b, int& R, int& C) { const int st = b / 1024, sb = b % 1024, swz = sb ^ (((sb >> 9) & 1) << 5); R = (st >> 1) * 16 + swz / 64; C = (st & 1) * 32 + (swz % 64) / 2; }
__host__ __device__ __forceinline__ int perm32(int rho) { const int n = rho >> 4, i = rho & 15; return 8 * (i >> 2) + 4 * n + (i & 3); }

struct Unit { int pm, pn; };
struct Gemm { const bf16_t* A; const bf16_t* Bt; int M, N, K, lda, ldb; };

struct StaticOrder {
    int nM, nN, nwg, G, c;
    __host__ __device__ void init(int M, int N, int G_, int c_) { nM = M / BM; nN = N / BM; nwg = nM * nN; G = G_; c = c_; }
    __host__ __device__ bool next(int i, Unit& u) const {
        const int L = i * G + c; if (L >= nwg) return false;
        int wgid = L; { const int q = nwg / NXCD, r = nwg % NXCD, xcd = wgid % NXCD, off = wgid / NXCD; wgid = (xcd < r ? xcd * (q + 1) : r * (q + 1) + (xcd - r) * q) + off; }
        const int nig = WGM * nN, gid = wgid / nig, fm = gid * WGM, gsz = (nM - fm) < WGM ? (nM - fm) : WGM;
        u.pm = fm + ((wgid % nig) % gsz); u.pn = (wgid % nig) / gsz; return true;
    }
    __device__ __forceinline__ void a_ready(const Unit&) const {}
    __device__ __forceinline__ void done(const Unit&) const {}
};

__device__ __forceinline__ unsigned cvt_pk_bf16(float lo, float hi) { unsigned r; asm volatile("v_cvt_pk_bf16_f32 %0, %1, %2" : "=v"(r) : "v"(lo), "v"(hi)); return r; }
typedef float f32x2 __attribute__((ext_vector_type(2)));
__device__ __forceinline__ unsigned pk2e(float lo, float hi) { typedef float v2f __attribute__((ext_vector_type(2))); typedef __bf16 v2b __attribute__((ext_vector_type(2))); v2f v = {lo, hi}; v2b b = __builtin_convertvector(v, v2b); return __builtin_bit_cast(unsigned, b); }
struct EpiStore {
    static constexpr bool PERM = true, AFTER_DRAIN = false;
    bf16_t* O0; int ld0; int split_col; bf16_t* O1; int ld1; int act;
    __device__ __forceinline__ void operator()(const f32x4 (&acc)[2][2][4][2], const Unit& u, int wr, int wc, int fr_, int fq_) const {
        int ln_ = threadIdx.x & 63; asm volatile("" : "+v"(ln_)); const int fr = ln_ & 15, fq = ln_ >> 4; (void)fr_; (void)fq_;
        const int row0 = u.pm * BM + wr * 64 + fr; int colt = u.pn * BM; bf16_t* base = O0; int ld = ld0;
        if (split_col && colt >= split_col) { base = O1; ld = ld1; colt -= split_col; }
        const int col0 = colt + wc * 32 + 8 * fq;
#pragma unroll
        for (int ai = 0; ai < 2; ++ai)
#pragma unroll
            for (int m = 0; m < 4; ++m) { bf16_t* rowp = base + (size_t)(row0 + ai * HALF + m * 16) * ld + col0;
#pragma unroll
                for (int bj = 0; bj < 2; ++bj) { f32x4 v0 = acc[ai][bj][m][0], v1 = acc[ai][bj][m][1];
                    if (act) {
#pragma unroll
                        for (int e = 0; e < 4; ++e) { float a = v0[e] > 0.f ? v0[e] : 0.f; v0[e] = a * a; float b = v1[e] > 0.f ? v1[e] : 0.f; v1[e] = b * b; } }
                    u32x4 w; w.x = pk2e(v0[0], v0[1]); w.y = pk2e(v0[2], v0[3]); w.z = pk2e(v1[0], v1[1]); w.w = pk2e(v1[2], v1[3]);
                    if (act) { const bf16_t* ap_ = rowp + bj * HALF; asm volatile("global_store_dwordx4 %0, %1, off nt\n\ts_nop 1" :: "v"(ap_), "v"(w) : "memory"); }
                    else *(u32x4*)(rowp + bj * HALF) = w; } }
    }
};
template <int MODE> struct EpiRope {
    static constexpr bool PERM = false, AFTER_DRAIN = false;
    bf16_t* O0; int ld0; int split_col; bf16_t* O1; int ld1; float qscale; const float* tab; int tlat;
    __device__ __forceinline__ void operator()(const f32x4 (&acc)[2][2][4][2], const Unit& u, int wr, int wc, int fr_, int fq_) const {
        int ln_ = threadIdx.x & 63; asm volatile("" : "+v"(ln_)); const int fr = ln_ & 15, fq = ln_ >> 4; (void)fr_; (void)fq_;
        typedef unsigned u32x2v __attribute__((ext_vector_type(2)));
        int colt = u.pn * BM; bf16_t* base = O0; int ld = ld0; float sc = qscale;
        const int gcolt = colt;
        if (split_col && colt >= split_col) { base = O1; ld = ld1; colt -= split_col; sc = 1.f; }
#pragma unroll
        for (int ai = 0; ai < 2; ++ai)
#pragma unroll
            for (int m = 0; m < 4; ++m) {
                const int row = u.pm * BM + ai * HALF + wr * 64 + m * 16 + fr;
                const bool lat = row < tlat; const int s = row & 4095, prow = s >> 6, pcol = s & 63;
                bf16_t* rowp = base + (size_t)row * ld + colt + wc * 32 + 4 * fq;
#pragma unroll
                for (int bj = 0; bj < 2; ++bj) {
                    if (MODE == 0) {
                        const int pos = (wc & 1) ? pcol : prow;
                        const f32x4* tp = (const f32x4*)(tab + (size_t)(pos * 16 + 4 * fq) * 2);
                        const f32x4 t0 = tp[0], t1 = tp[1];
                        const f32x4 x1 = acc[ai][bj][m][0], x2 = acc[ai][bj][m][1];
                        const float cs[4] = {t0[0], t0[2], t1[0], t1[2]}, sn[4] = {t0[1], t0[3], t1[1], t1[3]};
                        float o1[4], o2[4];
#pragma unroll
                        for (int e = 0; e < 4; ++e) { o1[e] = lat ? x1[e] * cs[e] - x2[e] * sn[e] : x1[e]; o2[e] = lat ? x2[e] * cs[e] + x1[e] * sn[e] : x2[e]; o1[e] *= sc; o2[e] *= sc; }
                        u32x2v w1, w2; w1.x = pk2e(o1[0], o1[1]); w1.y = pk2e(o1[2], o1[3]); w2.x = pk2e(o2[0], o2[1]); w2.y = pk2e(o2[2], o2[3]);
                        *(u32x2v*)(rowp + bj * HALF) = w1; *(u32x2v*)(rowp + bj * HALF + 16) = w2;
                    } else {
#pragma unroll
                        for (int n = 0; n < 2; ++n) {
                            const int c0 = gcolt + bj * HALF + wc * 32 + 16 * n; const int cc = c0 % 96;
                            const f32x4 x = acc[ai][bj][m][n]; float o[4] = {x[0], x[1], x[2], x[3]};
                            if (cc >= 64) {
                                const int pos = (cc >= 80) ? pcol : prow;
                                const f32x4* tp = (const f32x4*)(tab + (size_t)(pos * 8 + 4 * (fq & 1)) * 2);
                                const f32x4 t0 = tp[0], t1 = tp[1];
                                const float cs[4] = {t0[0], t0[2], t1[0], t1[2]}, sn[4] = {t0[1], t0[3], t1[1], t1[3]};
#pragma unroll
                                for (int e = 0; e < 4; ++e) { const float p = __shfl_xor(x[e], 32); const float r = (fq < 2) ? x[e] * cs[e] - p * sn[e] : x[e] * cs[e] + p * sn[e]; o[e] = lat ? r : x[e]; }
                            }
                            u32x2v w; w.x = pk2e(o[0] * sc, o[1] * sc); w.y = pk2e(o[2] * sc, o[3] * sc);
                            *(u32x2v*)(rowp + bj * HALF + 16 * n) = w;
                        }
                    }
                }
            }
    }
};
__device__ __forceinline__ float epi_shx(float v, int o, int lane) { return __int_as_float(__builtin_amdgcn_ds_bpermute((lane ^ o) << 2, __float_as_int(v))); }
struct EpiFuse {
    static constexpr bool PERM = true, AFTER_DRAIN = false;
    const float* hin; float* hout; bf16_t* U;
    const float* gY; const float* gate; const float* gU; const float* scale; const float* shift;
    float* X; unsigned* cnt; unsigned target0; PG8_LAS unsigned char* scr; float eps;
    __device__ __forceinline__ void xchg(const float (&ss)[2][4], float (&rs)[2][4], const Unit& u, int wr, int wc, int fr, int fq, int tid, int which) const {
        PG8_LAS float* P = (PG8_LAS float*)scr; PG8_LAS float* S = (PG8_LAS float*)(scr + 4096);
        if (fq == 0) {
#pragma unroll
            for (int ai = 0; ai < 2; ++ai)
#pragma unroll
                for (int m = 0; m < 4; ++m) P[(ai * 128 + wr * 64 + m * 16 + fr) * 4 + wc] = ss[ai][m]; }
        asm volatile("s_waitcnt lgkmcnt(0)" ::: "memory"); __builtin_amdgcn_s_barrier(); asm volatile("" ::: "memory");
        float* Xe = X + (size_t)which * (128 * 4 * 256) + (size_t)u.pm * 1024;
        unsigned* c = cnt + 64 * u.pm;
        if (tid < 256) { const f32x4 p = *(const PG8_LAS f32x4*)(P + tid * 4);
            __hip_atomic_store(Xe + u.pn * 256 + tid, (p[0] + p[1]) + (p[2] + p[3]), __ATOMIC_RELAXED, __HIP_MEMORY_SCOPE_AGENT); }
        asm volatile("s_waitcnt vmcnt(0)" ::: "memory");
        if (tid < 256 && (tid & 63) == 0) __hip_atomic_fetch_add(c, 1u, __ATOMIC_RELAXED, __HIP_MEMORY_SCOPE_AGENT);
        if (tid < 64) { const unsigned want = target0 + 16u * (unsigned)which; unsigned spins = 0;
            while ((unsigned)__builtin_amdgcn_readfirstlane(__hip_atomic_load(c, __ATOMIC_RELAXED, __HIP_MEMORY_SCOPE_AGENT)) < want) { __builtin_amdgcn_s_sleep(1); if (++spins > (1u << 20)) break; }
            __builtin_amdgcn_fence(__ATOMIC_ACQUIRE, "agent"); }
        asm volatile("s_waitcnt vmcnt(0) lgkmcnt(0)" ::: "memory"); __builtin_amdgcn_s_barrier(); asm volatile("" ::: "memory");
        if (tid < 256) { float t = 0.f;
#pragma unroll
            for (int q = 0; q < 4; ++q) t += __hip_atomic_load(Xe + q * 256 + tid, __ATOMIC_RELAXED, __HIP_MEMORY_SCOPE_AGENT);
            S[tid] = 1.0f / sqrtf(t * (1.f / 1024.f) + eps); }
        asm volatile("s_waitcnt vmcnt(0) lgkmcnt(0)" ::: "memory"); __builtin_amdgcn_s_barrier(); asm volatile("" ::: "memory");
#pragma unroll
        for (int ai = 0; ai < 2; ++ai)
#pragma unroll
            for (int m = 0; m < 4; ++m) rs[ai][m] = S[ai * 128 + wr * 64 + m * 16 + fr];
        asm volatile("s_waitcnt lgkmcnt(0)" ::: "memory");
    }
    __device__ __forceinline__ void operator()(f32x4 (&acc)[2][2][4][2], const Unit& u, int wr, int wc, int fr_, int fq_) const {
        int tid = threadIdx.x; asm volatile("" : "+v"(tid)); const int ln = tid & 63, fr = ln & 15, fq = ln >> 4; (void)fr_; (void)fq_;
        const int b = (u.pm * BM) >> 12; const int colb = u.pn * BM + wc * 32 + 8 * fq; const int row0 = u.pm * BM + wr * 64 + fr;
        float ss[2][4], rs[2][4];
#pragma unroll
        for (int ai = 0; ai < 2; ++ai)
#pragma unroll
            for (int m = 0; m < 4; ++m) { float s = 0.f;
#pragma unroll
                for (int bj = 0; bj < 2; ++bj)
#pragma unroll
                    for (int n = 0; n < 2; ++n) { const f32x4 v = acc[ai][bj][m][n]; s += (v[0] * v[0] + v[1] * v[1]) + (v[2] * v[2] + v[3] * v[3]); }
                s += epi_shx(s, 16, ln); s += epi_shx(s, 32, ln); ss[ai][m] = s; }
        f32x4 H[2][2][2];
#define EF_LOADH(ai_, mp_) do { _Pragma("unroll") for (int mm = 0; mm < 2; ++mm) { const size_t ro_ = (size_t)(row0 + (ai_) * HALF + (2 * (mp_) + mm) * 16) * 1024 + colb; \
            _Pragma("unroll") for (int bj = 0; bj < 2; ++bj) _Pragma("unroll") for (int n = 0; n < 2; ++n) H[mm][bj][n] = *(const f32x4*)(hin + ro_ + bj * HALF + 4 * n); } } while (0)
        EF_LOADH(0, 0);
        xchg(ss, rs, u, wr, wc, fr, fq, tid, 0);
        { f32x4 G[2][2];
#pragma unroll
          for (int bj = 0; bj < 2; ++bj)
#pragma unroll
              for (int n = 0; n < 2; ++n) G[bj][n] = *(const f32x4*)(gate + (size_t)b * 6144 + colb + bj * HALF + 4 * n) * *(const f32x4*)(gY + colb + bj * HALF + 4 * n);
#pragma unroll
          for (int ai = 0; ai < 2; ++ai)
#pragma unroll
              for (int mp = 0; mp < 2; ++mp) {
                  if (ai + mp > 0) EF_LOADH(ai, mp);
#pragma unroll
                  for (int mm = 0; mm < 2; ++mm) { const int m = 2 * mp + mm; const size_t ro = (size_t)(row0 + ai * HALF + m * 16) * 1024 + colb; float s = 0.f;
#pragma unroll
                      for (int bj = 0; bj < 2; ++bj)
#pragma unroll
                          for (int n = 0; n < 2; ++n) { const f32x4 v = H[mm][bj][n] + G[bj][n] * (acc[ai][bj][m][n] * rs[ai][m]);
                              *(f32x4*)(hout + ro + bj * HALF + 4 * n) = v; acc[ai][bj][m][n] = v; s += (v[0] * v[0] + v[1] * v[1]) + (v[2] * v[2] + v[3] * v[3]); }
                      s += epi_shx(s, 16, ln); s += epi_shx(s, 32, ln); ss[ai][m] = s; } } }
#undef EF_LOADH
        if (U) {
            xchg(ss, rs, u, wr, wc, fr, fq, tid, 1);
            f32x4 A2[2][2], B2[2][2];
#pragma unroll
            for (int bj = 0; bj < 2; ++bj)
#pragma unroll
                for (int n = 0; n < 2; ++n) { A2[bj][n] = *(const f32x4*)(gU + colb + bj * HALF + 4 * n) * (*(const f32x4*)(scale + (size_t)b * 6144 + colb + bj * HALF + 4 * n) + 1.f);
                    B2[bj][n] = *(const f32x4*)(shift + (size_t)b * 6144 + colb + bj * HALF + 4 * n); }
#pragma unroll
            for (int ai = 0; ai < 2; ++ai)
#pragma unroll
                for (int m = 0; m < 4; ++m) { bf16_t* up = U + (size_t)(row0 + ai * HALF + m * 16) * 1024 + colb;
#pragma unroll
                    for (int bj = 0; bj < 2; ++bj) { const f32x4 v0 = (acc[ai][bj][m][0] * rs[ai][m]) * A2[bj][0] + B2[bj][0], v1 = (acc[ai][bj][m][1] * rs[ai][m]) * A2[bj][1] + B2[bj][1];
                        u32x4 w; w.x = pk2e(v0[0], v0[1]); w.y = pk2e(v0[2], v0[3]); w.z = pk2e(v1[0], v1[1]); w.w = pk2e(v1[2], v1[3]); *(u32x4*)(up + bj * HALF) = w; } }
        }
    }
};
template <class Epi, class Sched, bool ALIGN_EPI = false, bool SP2 = false>
__device__ __forceinline__ void gemm_phase(PG8_LAS unsigned char* lds, const Gemm g, const Sched& S, const Epi& E) {
    int tid_l = threadIdx.x; asm volatile("" : "+v"(tid_l)); const int tid = tid_l, wid = __builtin_amdgcn_readfirstlane(tid >> 6), lane = tid & 63, wr = wid >> 2, wc = wid & 3, fr = lane & 15, fq = lane >> 4;
    const int K = g.K, nt = K / BK;
    unsigned voffA[2], voffB[2];
#pragma unroll
    for (int i = 0; i < 2; ++i) { int R, C; stage_rc(tid * 16 + i * 8192, R, C); const int Rb = Epi::PERM ? ((R & ~31) + perm32(R & 31)) : R;
        voffA[i] = (unsigned)(R * g.lda + C) * 2u; voffB[i] = (unsigned)(Rb * g.ldb + C) * 2u; }
    const size_t kstep = (size_t)(BK * 2);
    const size_t hstepA = (size_t)HALF * g.lda * 2, hstepB = (size_t)HALF * g.ldb * 2;
    const size_t tstepA = 2 * hstepA, tstepB = 2 * hstepB;
    const unsigned ldsw = (unsigned)wid * 1024u;
    const int aoff = lds_byte(wr * 64 + fr, fq * 8), boff = lds_byte(wc * 32 + fr, fq * 8);
#define PG8_SA(b, h) (((b) * 2 + (h)) * HTB)
#define PG8_SB(b, h) ((4 + (b) * 2 + (h)) * HTB)
#define PG8_STAGE(bufoff, gbase, voff) do { _Pragma("unroll") for (int _i = 0; _i < 2; ++_i) \
        __builtin_amdgcn_global_load_lds((const unsigned*)((const char*)(gbase) + (voff)[_i]), (PG8_LAS unsigned*)(lds + (bufoff) + ldsw + _i * 8192), 16, 0, 0); } while (0)
#define PG8_LDA(dst, b, h) do { _Pragma("unroll") for (int m = 0; m < 4; ++m) _Pragma("unroll") for (int k = 0; k < 2; ++k) dst[m][k] = *(const PG8_LAS bf16x8*)(lds + PG8_SA(b, h) + aoff + m * 2048 + k * 1024); } while (0)
#define PG8_LDB(dst, b, h) do { _Pragma("unroll") for (int n = 0; n < 2; ++n) _Pragma("unroll") for (int k = 0; k < 2; ++k) dst[n][k] = *(const PG8_LAS bf16x8*)(lds + PG8_SB(b, h) + boff + n * 2048 + k * 1024); } while (0)
#define PG8_MMA(ai, bj, At, Bt) do { __builtin_amdgcn_s_setprio(1); _Pragma("unroll") for (int m = 0; m < 4; ++m) _Pragma("unroll") for (int n = 0; n < 2; ++n) _Pragma("unroll") for (int k = 0; k < 2; ++k) \
        acc[ai][bj][m][n] = __builtin_amdgcn_mfma_f32_16x16x32_bf16(Bt[n][k], At[m][k], acc[ai][bj][m][n], 0, 0, 0); __builtin_amdgcn_s_setprio(0); } while (0)
#define PG8_WAIT_V(n) asm volatile("s_waitcnt vmcnt(" #n ")" ::: "memory")
#define PG8_WAIT_L(n) asm volatile("s_waitcnt lgkmcnt(" #n ")" ::: "memory")
#define PG8_BAR __builtin_amdgcn_s_barrier()
#define PG8_SCHED __builtin_amdgcn_sched_barrier(0)
    Unit cur, nxt; int ui = 0;
    if (!S.next(0, cur)) return;
    f32x4 acc[2][2][4][2];
#pragma unroll
    for (int a = 0; a < 2; ++a)
#pragma unroll
        for (int b = 0; b < 2; ++b)
#pragma unroll
            for (int m = 0; m < 4; ++m)
#pragma unroll
                for (int n = 0; n < 2; ++n) acc[a][b][m][n] = (f32x4){0.f, 0.f, 0.f, 0.f};
    bf16x8 At[4][2], B0[2][2], B1[2][2];
    const char* cA = (const char*)g.A + (size_t)cur.pm * tstepA; const char* cB = (const char*)g.Bt + (size_t)cur.pn * tstepB;
    S.a_ready(cur);
    if constexpr (SP2) {
        PG8_STAGE(PG8_SB(0, 0), cB, voffB); PG8_STAGE(PG8_SB(0, 1), cB + hstepB, voffB); PG8_STAGE(PG8_SA(0, 0), cA, voffA); PG8_STAGE(PG8_SA(0, 1), cA + hstepA, voffA);
        if (wr == 1) PG8_BAR;
        PG8_WAIT_V(2); PG8_BAR;
        PG8_STAGE(PG8_SB(1, 0), cB + kstep, voffB); PG8_STAGE(PG8_SA(1, 0), cA + kstep, voffA); PG8_STAGE(PG8_SB(1, 1), cB + hstepB + kstep, voffB);
        PG8_WAIT_V(6); PG8_BAR;
    } else {
        PG8_STAGE(PG8_SB(0, 0), cB, voffB); PG8_STAGE(PG8_SA(0, 0), cA, voffA); PG8_STAGE(PG8_SB(0, 1), cB + hstepB, voffB); PG8_STAGE(PG8_SA(0, 1), cA + hstepA, voffA);
        if (wr == 1) PG8_BAR;
        PG8_WAIT_V(4); PG8_BAR;
        PG8_STAGE(PG8_SB(1, 0), cB + kstep, voffB); PG8_STAGE(PG8_SA(1, 0), cA + kstep, voffA); PG8_STAGE(PG8_SB(1, 1), cB + hstepB + kstep, voffB);
        PG8_WAIT_V(6); PG8_BAR;
    }
    for (;;) {
        const bool has_next = S.next(ui + 1, nxt);
        const char* nA = has_next ? (const char*)g.A + (size_t)nxt.pm * tstepA : cA; const char* nB = has_next ? (const char*)g.Bt + (size_t)nxt.pn * tstepB : cB;
        for (int t = 0; t < nt; t += 2) {
            const bool last = (t == nt - 2);
            const char* a1 = cA + (size_t)(t + 1) * kstep;
            const char* a2 = last ? nA : cA + (size_t)(t + 2) * kstep; const char* b2 = last ? nB : cB + (size_t)(t + 2) * kstep;
            const char* a3 = a2 + kstep; const char* b3 = b2 + kstep;
            if (last && has_next) S.a_ready(nxt);
            if constexpr (SP2) {
            PG8_LDB(B0, 0, 0); PG8_LDB(B1, 0, 1); PG8_SCHED; PG8_LDA(At, 0, 0); PG8_STAGE(PG8_SA(1, 1), a1 + hstepA, voffA);
            PG8_WAIT_V(8); PG8_WAIT_L(0); PG8_BAR; PG8_MMA(0, 0, At, B0); PG8_MMA(0, 1, At, B1); PG8_BAR; PG8_SCHED;
            PG8_LDA(At, 0, 1); PG8_STAGE(PG8_SB(0, 0), b2, voffB); PG8_STAGE(PG8_SB(0, 1), b2 + hstepB, voffB); PG8_STAGE(PG8_SA(0, 0), a2, voffA);
            PG8_WAIT_V(8); PG8_WAIT_L(0); PG8_BAR; PG8_MMA(1, 0, At, B0); PG8_MMA(1, 1, At, B1); PG8_BAR; PG8_SCHED;
            PG8_LDB(B0, 1, 0); PG8_LDB(B1, 1, 1); PG8_SCHED; PG8_LDA(At, 1, 0); PG8_STAGE(PG8_SA(0, 1), a2 + hstepA, voffA);
            PG8_WAIT_V(8); PG8_WAIT_L(0); PG8_BAR; PG8_MMA(0, 0, At, B0); PG8_MMA(0, 1, At, B1); PG8_BAR; PG8_SCHED;
            PG8_LDA(At, 1, 1); PG8_STAGE(PG8_SB(1, 0), b3, voffB); PG8_STAGE(PG8_SB(1, 1), b3 + hstepB, voffB); PG8_STAGE(PG8_SA(1, 0), a3, voffA);
            PG8_WAIT_V(8); PG8_WAIT_L(0); PG8_BAR; PG8_MMA(1, 0, At, B0); PG8_MMA(1, 1, At, B1); PG8_BAR; PG8_SCHED;
            } else {
            PG8_LDB(B0, 0, 0); PG8_SCHED; PG8_LDA(At, 0, 0); PG8_STAGE(PG8_SA(1, 1), a1 + hstepA, voffA);
            PG8_WAIT_L(8); PG8_BAR; PG8_WAIT_L(0); PG8_MMA(0, 0, At, B0); PG8_BAR; PG8_SCHED;
            PG8_LDB(B1, 0, 1); PG8_STAGE(PG8_SB(0, 0), b2, voffB);
            PG8_BAR; PG8_WAIT_L(0); PG8_MMA(0, 1, At, B1); PG8_BAR;
            PG8_LDA(At, 0, 1); PG8_STAGE(PG8_SA(0, 0), a2, voffA);
            PG8_BAR; PG8_WAIT_L(0); PG8_MMA(1, 0, At, B0); PG8_BAR; PG8_SCHED;
            PG8_STAGE(PG8_SB(0, 1), b2 + hstepB, voffB);
            PG8_WAIT_V(6); PG8_BAR; PG8_MMA(1, 1, At, B1); PG8_BAR;
            PG8_LDB(B0, 1, 0); PG8_SCHED; PG8_LDA(At, 1, 0); PG8_STAGE(PG8_SA(0, 1), a2 + hstepA, voffA);
            PG8_WAIT_L(8); PG8_BAR; PG8_WAIT_L(0); PG8_MMA(0, 0, At, B0); PG8_BAR; PG8_SCHED;
            PG8_LDB(B1, 1, 1); PG8_STAGE(PG8_SB(1, 0), b3, voffB);
            PG8_BAR; PG8_WAIT_L(0); PG8_MMA(0, 1, At, B1); PG8_BAR;
            PG8_LDA(At, 1, 1); PG8_STAGE(PG8_SA(1, 0), a3, voffA);
            PG8_BAR; PG8_WAIT_L(0); PG8_MMA(1, 0, At, B0); PG8_BAR; PG8_SCHED;
            PG8_STAGE(PG8_SB(1, 1), b3 + hstepB, voffB);
            PG8_WAIT_V(6); PG8_BAR; PG8_MMA(1, 1, At, B1); PG8_BAR;
            }
        }
        if constexpr (ALIGN_EPI) { if (wr == 0) PG8_BAR; }
        if constexpr (!Epi::AFTER_DRAIN) { E(acc, cur, wr, wc, fr, fq); S.done(cur); }
        if (!has_next) break;
#pragma unroll
        for (int a = 0; a < 2; ++a)
#pragma unroll
            for (int b = 0; b < 2; ++b)
#pragma unroll
                for (int m = 0; m < 4; ++m)
#pragma unroll
                    for (int n = 0; n < 2; ++n) acc[a][b][m][n] = (f32x4){0.f, 0.f, 0.f, 0.f};
        cur = nxt; cA = nA; cB = nB; ++ui;
        if constexpr (ALIGN_EPI) { if (wr == 1) PG8_BAR; }
    }
    PG8_WAIT_V(0);
    if constexpr (!ALIGN_EPI) { if (wr == 0) PG8_BAR; }
    PG8_BAR;
    if constexpr (Epi::AFTER_DRAIN) { E.fused(acc, cur, wr, wc, fr, fq, lds, wid, lane); S.done(cur); }
#undef PG8_SA
#undef PG8_SB
#undef PG8_STAGE
#undef PG8_LDA
#undef PG8_LDB
#undef PG8_MMA
#undef PG8_WAIT_V
#undef PG8_WAIT_L
#undef PG8_BAR
#undef PG8_SCHED
}
}
#define LAS __attribute__((address_space(3)))
typedef unsigned short bf16;
typedef short bf16x8 __attribute__((ext_vector_type(8)));
typedef float f32x4 __attribute__((ext_vector_type(4)));
typedef float f32x16 __attribute__((ext_vector_type(16)));
typedef unsigned u32x4 __attribute__((ext_vector_type(4)));
typedef unsigned u32x2 __attribute__((ext_vector_type(2)));
typedef float f32x2_t __attribute__((ext_vector_type(2)));
typedef __bf16 bf16x2_t __attribute__((ext_vector_type(2)));

constexpr int D = 1024, NB = 8, SEQ = 4096, CTXL = 256, FF = 4096;
constexpr int TL = NB * SEQ, TC = NB * CTXL, MT = TL + TC;
constexpr float EPS = 1e-6f, LOG2E = 1.4426950408889634f;
constexpr int NTHREADS = 512, NWAVES = 8;
constexpr size_t MiB = 1u << 20;
constexpr size_t WS_TAB = 0;
constexpr size_t WS_XBAR = 32768;
constexpr size_t WS_XCNT = 49152;
constexpr size_t WS_XBUF = 38 * MiB;
constexpr size_t WS_MODS = 1 * MiB;
constexpr size_t WS_HC = 2 * MiB;
constexpr size_t WS_KR = 10 * MiB;
constexpr size_t WS_W = 14 * MiB;
constexpr size_t WS_WSTRIDE = 26 * MiB;
constexpr size_t WS_U = 66 * MiB;
constexpr size_t WS_Y = 134 * MiB;
constexpr size_t WS_BIG = 202 * MiB;
constexpr size_t WS_YP = 474 * MiB;
constexpr size_t WS_END = 506 * MiB;
constexpr size_t WO_W1 = 0, WO_W2 = 4u << 20, WO_WO = 8u << 20, WO_MIX = 9u << 20;
constexpr int LDS_BYTES = 147456;
constexpr int MODS_PER_LAYER = 9 * 6144;

__device__ __forceinline__ unsigned pk2(float lo, float hi) { f32x2_t v = {lo, hi}; bf16x2_t b = __builtin_convertvector(v, bf16x2_t); return __builtin_bit_cast(unsigned, b); }
__device__ __forceinline__ float bflo(unsigned u) { return __uint_as_float(u << 16); }
__device__ __forceinline__ float bfhi(unsigned u) { return __uint_as_float(u & 0xffff0000u); }
__device__ __forceinline__ float shx(float v, int o, int lane) { return __int_as_float(__builtin_amdgcn_ds_bpermute((lane ^ o) << 2, __float_as_int(v))); }
__device__ __forceinline__ float wave_sum(float v, int lane) {
#pragma unroll
    for (int o = 1; o < 64; o <<= 1) v += shx(v, o, lane);
    return v;
}
__device__ __forceinline__ float xor32(float v, int hh) {
    const unsigned u = __float_as_uint(v);
    auto r = __builtin_amdgcn_permlane32_swap(u, u, false, false);
    return __uint_as_float(hh ? r[0] : r[1]);
}

struct LayerPtrs { const float *ada_w, *ada_b, *norms, *w_a, *w_o, *w1, *w2, *x0, *x1, *w_uq, *w_ukv; };
struct Params { const float *x, *c, *ctx, *c_ctx; float* out; unsigned char* ws; LayerPtrs L[4]; };
#define XB_TMO      128
#define XB_XCNT(j)  (256  + 64 * (j))
#define XB_XSUB(j)  (1280 + 64 * (j))
#define XB_XGEN(j)  (2304 + 64 * (j))
#define XB_TOP      3328
#define XB_TOPGEN   3392
#define XCD_BAR_WORDS 3456
#define XB_SPIN_CAP (1u << 18)

__device__ __forceinline__ unsigned xb_ld(unsigned* p)              { return __hip_atomic_load(p, __ATOMIC_RELAXED, __HIP_MEMORY_SCOPE_AGENT); }
__device__ __forceinline__ unsigned xb_add(unsigned* p, unsigned v) { return __hip_atomic_fetch_add(p, v, __ATOMIC_RELAXED, __HIP_MEMORY_SCOPE_AGENT); }
__device__ __forceinline__ unsigned xb_xcc_id() { return (unsigned)__builtin_amdgcn_s_getreg((3 << 11) | 20) & 0xFu; }
#define XB_SPIN(cond, bar) do { unsigned _sp = 0; while (cond) { __builtin_amdgcn_s_sleep(1); \
    if ((++_sp & 255u) == 0u) { if (xb_ld(&(bar)[XB_TMO])) break; if (_sp > XB_SPIN_CAP) { atomicAdd(&(bar)[XB_TMO], 1u); break; } } } } while (0)

struct XcdBarrier {
    unsigned* bar; unsigned x;
    volatile LAS unsigned* st;
};

__device__ __forceinline__ XcdBarrier xcd_barrier_post(unsigned* bar, volatile LAS unsigned* st) {
    XcdBarrier b; b.bar = bar; b.x = xb_xcc_id(); b.st = st;
    if (threadIdx.x == 0) (void)xb_add(&bar[XB_XCNT(b.x)], 1u);
    return b;
}
__device__ __forceinline__ void xcd_barrier_complete(unsigned* bar, unsigned x, unsigned& nloc, unsigned& nx) {
    const unsigned G = gridDim.x * gridDim.y * gridDim.z;
    unsigned sum, cnt, mine, sp = 0u;
    for (;;) {
        sum = 0u; cnt = 0u; mine = 0u;
#pragma unroll
        for (unsigned j = 0; j < 16; ++j) { const unsigned c = xb_ld(&bar[XB_XCNT(j)]); sum += c; cnt += (c > 0u) ? 1u : 0u; mine = (j == x) ? c : mine; }
        if (sum == G) break;
        __builtin_amdgcn_s_sleep(1);
        if ((++sp & 255u) == 0u) { if (xb_ld(&bar[XB_TMO])) break; if (sp > XB_SPIN_CAP) { atomicAdd(&bar[XB_TMO], 1u); break; } }
    }
    nloc = mine > 0u ? mine : 1u; nx = cnt > 0u ? cnt : 1u;
}

__device__ __forceinline__ void xcd_barrier(const XcdBarrier& b) {
    asm volatile("s_waitcnt vmcnt(0)" ::: "memory");
    __syncthreads();
    if (threadIdx.x == 0) {
        unsigned* bar = b.bar;
        __builtin_amdgcn_s_waitcnt(0);
        unsigned nloc = b.st[0], nx = b.st[1];
        if (nloc == 0u) { xcd_barrier_complete(bar, b.x, nloc, nx); b.st[0] = nloc; b.st[1] = nx; }
        const unsigned old = xb_add(&bar[XB_XSUB(b.x)], 1u);
        const unsigned gen = old / nloc;
        if (old + 1u == (gen + 1u) * nloc) {
            __builtin_amdgcn_fence(__ATOMIC_RELEASE, "agent");
            asm volatile("s_waitcnt vmcnt(0)" ::: "memory");
            const unsigned og = xb_add(&bar[XB_TOP], 1u);
            const unsigned tg = og / nx;
            if (og + 1u == (tg + 1u) * nx) xb_add(&bar[XB_TOPGEN], 1u);
            else XB_SPIN(xb_ld(&bar[XB_TOPGEN]) == tg, bar);
            __builtin_amdgcn_fence(__ATOMIC_ACQUIRE, "agent");
            xb_add(&bar[XB_XGEN(b.x)], 1u);
            asm volatile("s_waitcnt vmcnt(0)" ::: "memory");
        } else {
            XB_SPIN(xb_ld(&bar[XB_XGEN(b.x)]) == gen, bar);
            __builtin_amdgcn_fence(__ATOMIC_ACQUIRE, "agent");
            asm volatile("s_waitcnt vmcnt(0)" ::: "memory");
        }
    }
    __syncthreads();
}
constexpr float AT_THR = 24.f;
#define AT_BAR() do { asm volatile("s_waitcnt lgkmcnt(0)" ::: "memory"); __builtin_amdgcn_s_barrier(); asm volatile("" ::: "memory"); } while (0)
constexpr int AT_KB = 12288, AT_VB = 16384, AT_K0 = 0, AT_V0 = 3 * AT_KB;
template <int DQ, int DV, bool WINDOW, bool GQA = false>
__device__ __forceinline__ void attn_phase(LAS unsigned char* lds, const bf16* __restrict__ Q, int ldq, const bf16* __restrict__ K1, int ldk, int kshift,
                                           const bf16* __restrict__ KR, const bf16* __restrict__ Vt, int vshift, bf16* __restrict__ O, int ldo,
                                           const float* __restrict__ sink, int nunits_lat, int nunits_ctx) {
    constexpr int NKS = DQ / 16, NV = DV / 32, KROWB = DQ * 2, NVL = DV / 64, NKL = (DQ == 64) ? 1 : 2;
    int tid_l = threadIdx.x; asm volatile("" : "+v"(tid_l)); const int tid = tid_l, lane = tid & 63, wave = __builtin_amdgcn_readfirstlane(tid >> 6), r32 = lane & 31, hh = lane >> 5;
    int grp;
    { LAS unsigned* cnt = (LAS unsigned*)(lds + 138240);
      if (tid < 4) cnt[tid] = 0u;
      AT_BAR();
      const unsigned simd = (unsigned)__builtin_amdgcn_s_getreg((1 << 11) | (4 << 6) | 4) & 3u;
      unsigned old = 0u; if (lane == 0) old = __hip_atomic_fetch_add(cnt + simd, 1u, __ATOMIC_RELAXED, __HIP_MEMORY_SCOPE_WORKGROUP);
      grp = (int)(__builtin_amdgcn_readfirstlane(old) & 1u);
      AT_BAR(); }
    const int pk = (r32 & ~0xC) | ((r32 & 4) << 1) | ((r32 & 8) >> 1);
    int koff[NKS];
#pragma unroll
    for (int ks = 0; ks < NKS; ++ks) { const int c = 2 * ks + hh; const int sw = (DQ == 64) ? ((pk >> 1) & 7) : ((pk >> 2) & 3); koff[ks] = pk * KROWB + ((c ^ sw) << 4); }
    int voff[4];
#pragma unroll
    for (int ts = 0; ts < 4; ++ts) voff[ts] = r32 * 128 + (((2 * ts + hh) ^ ((r32 >> 1) & 7)) << 4);
    const int nunits = nunits_lat + nunits_ctx;
    int bid_ = blockIdx.x; asm volatile("" : "+s"(bid_));
    const int gsz_ = gridDim.x; const int vcu_ = (gsz_ % 8 == 0) ? (bid_ % 8) * (gsz_ / 8) + bid_ / 8 : bid_;
    for (int u = vcu_; u < nunits; u += gsz_) {
        const bool isctx = u >= nunits_lat; int b, hq, qrow0;
        if (!GQA) { int qb; if (!isctx) { qb = u & 15; hq = (u >> 4) & 15; b = u >> 8; } else { const int v = u - nunits_lat; hq = v & 15; b = v >> 4; qb = 0; } qrow0 = qb * 256 + wave * 32; }
        else { int qb64, kvh; if (!isctx) { qb64 = u & 63; kvh = (u >> 6) & 3; b = u >> 8; } else { const int v = u - nunits_lat; qb64 = v & 3; kvh = (v >> 2) & 3; b = v >> 4; } hq = kvh * 4 + (wave >> 1); qrow0 = qb64 * 64 + (wave & 1) * 32; }
        const int ublk0 = GQA ? (qrow0 & ~63) : (qrow0 & ~255), ublen = GQA ? 64 : 256;
        const int mqw = (isctx ? TL + b * CTXL : b * SEQ) + qrow0;
        int lt0 = 0, nlt = 0;
        if (!isctx) { if (WINDOW) { const int lo = (ublk0 - 128) < 0 ? 0 : (ublk0 - 128); const int hi = (ublk0 + ublen + 128) > SEQ ? SEQ : (ublk0 + ublen + 128); lt0 = lo >> 6; nlt = (hi - lo) >> 6; } else { lt0 = 0; nlt = 64; } }
        const int nt = 4 + nlt;
        bf16x8 qf[NKS];
        { const bf16* qp = Q + (size_t)(mqw + r32) * ldq + hq * DQ + 8 * hh;
#pragma unroll
          for (int ks = 0; ks < NKS; ++ks) qf[ks] = *(const bf16x8*)(qp + 16 * ks); }
        float m_run, l_run;
        m_run = 0.f; l_run = (sink && hh == 0) ? __builtin_amdgcn_exp2f(sink[hq] * LOG2E) : 0.f;
        f32x16 o[NV];
#pragma unroll
        for (int v = 0; v < NV; ++v)
#pragma unroll
            for (int i = 0; i < 16; ++i) o[v][i] = 0.f;
        const bf16* kbase = K1 + (size_t)(hq >> kshift) * 64;
        const bf16* vbase = Vt + (size_t)((hq >> vshift) * DV) * MT;
        bf16x8 pf[2]; f32x16 s1k; bool pact = true;
#pragma unroll
        for (int i = 0; i < 16; ++i) s1k[i] = 0.f;
#define AT_M0(t) ((t) < 4 ? (TL + b * CTXL + 64 * (t)) : (b * SEQ + (lt0 + (t) - 4) * 64))
#define AT_DMA(src_, dst_) __builtin_amdgcn_global_load_lds((const unsigned*)(src_), (LAS unsigned*)(dst_), 16, 0, 0)
#define AT_LOADK(t, sl) do { const int m0_ = AT_M0(t); LAS unsigned char* kd_ = lds + AT_K0 + (sl) * AT_KB; \
        if (DQ == 64) { const int row = 8 * wave + (lane >> 3), c = (lane & 7) ^ ((row >> 1) & 7); AT_DMA(kbase + (size_t)(m0_ + row) * ldk + 8 * c, kd_ + 1024 * wave); } \
        else { _Pragma("unroll") for (int i = 0; i < 2; ++i) { const int piece = (i == 0) ? wave : (wave < 4 ? wave + 8 : wave); const int o_ = 1024 * piece + 16 * lane; \
                 const int row = o_ / 192, c = ((o_ % 192) >> 4) ^ ((row >> 2) & 3); \
                 const bf16* src = (c < 8) ? kbase + (size_t)(m0_ + row) * ldk + 8 * c : KR + (size_t)(m0_ + row) * 32 + 8 * (c - 8); AT_DMA(src, kd_ + 1024 * piece); } } } while (0)
#define AT_LOADV(t, sl) do { const int m0_ = AT_M0(t); LAS unsigned char* vd_ = lds + AT_V0 + (sl) * AT_VB; \
        _Pragma("unroll") for (int i = 0; i < NVL; ++i) { const int piece = wave + 8 * i; const int row = 8 * piece + (lane >> 3), c16 = (lane & 7) ^ ((row >> 1) & 7); \
            AT_DMA(vbase + (size_t)row * MT + m0_ + 8 * c16, vd_ + 1024 * piece); } } while (0)
#define AT_VMW(n) asm volatile("s_waitcnt vmcnt(%0)" :: "n"(n) : "memory")
#define AT_QKS(te, sl) do { \
        bool active = true; int kpos0 = 0; const bool lat_tile = (te) >= 4; \
        if (lat_tile) kpos0 = (lt0 + (te) - 4) * 64; \
        if (WINDOW && lat_tile) { const int qa = qrow0; active = (kpos0 + 63 >= qa - 128) && (kpos0 <= qa + 31 + 128); } \
        pact = active; \
        if (active) { \
            const LAS unsigned char* kb = lds + AT_K0 + (sl) * AT_KB; \
            f32x16 s0, s1; bf16x8 ka[NKS][2]; \
            _Pragma("unroll") for (int ks = 0; ks < NKS; ++ks) { ka[ks][0] = *(const LAS bf16x8*)(kb + koff[ks]); ka[ks][1] = *(const LAS bf16x8*)(kb + koff[ks] + 32 * KROWB); } \
            __builtin_amdgcn_sched_barrier(0); \
            { f32x16 z_; _Pragma("unroll") for (int i = 0; i < 16; ++i) z_[i] = 0.f; \
              s0 = __builtin_amdgcn_mfma_f32_32x32x16_bf16(ka[0][0], qf[0], z_, 0, 0, 0); s1 = __builtin_amdgcn_mfma_f32_32x32x16_bf16(ka[0][1], qf[0], z_, 0, 0, 0); } \
            _Pragma("unroll") for (int ks = 1; ks < NKS; ++ks) { s0 = __builtin_amdgcn_mfma_f32_32x32x16_bf16(ka[ks][0], qf[ks], s0, 0, 0, 0); s1 = __builtin_amdgcn_mfma_f32_32x32x16_bf16(ka[ks][1], qf[ks], s1, 0, 0, 0); } \
            __builtin_amdgcn_sched_barrier(0); \
            if (__any(m_run != 0.f)) { _Pragma("unroll") for (int i = 0; i < 16; ++i) { s0[i] -= m_run; s1[i] -= m_run; } }     \
            if (WINDOW && lat_tile) { \
                const int qp = qrow0 + r32; float negbig = -1e30f; asm volatile("" : "+v"(negbig)); \
                _Pragma("unroll") for (int i = 0; i < 16; ++i) { const int kr = kpos0 + (i & 3) + 4 * ((i >> 2) & 1) + 8 * hh + 16 * (i >> 3); const int d0 = qp - kr, d1 = qp - (kr + 32); \
                    if (d0 > 128 || d0 < -128) s0[i] = negbig; if (d1 > 128 || d1 < -128) s1[i] = negbig; } \
            } \
            float mx = s0[0]; \
            _Pragma("unroll") for (int i = 1; i < 16; ++i) mx = fmaxf(mx, s0[i]); \
            _Pragma("unroll") for (int i = 0; i < 16; ++i) mx = fmaxf(mx, s1[i]); \
            mx = fmaxf(mx, xor32(mx, hh)); \
            if (__any(mx > AT_THR)) { \
                const float delta = fmaxf(mx, 0.f); const float alpha = __builtin_amdgcn_exp2f(-delta); \
                m_run += delta; l_run *= alpha; \
                _Pragma("unroll") for (int i = 0; i < 16; ++i) { s0[i] -= delta; s1[i] -= delta; } \
                _Pragma("unroll") for (int v = 0; v < NV; ++v) _Pragma("unroll") for (int i = 0; i < 16; ++i) o[v][i] *= alpha; \
            } \
            float ps = 0.f; \
            _Pragma("unroll") for (int i = 0; i < 16; ++i) { s0[i] = __builtin_amdgcn_exp2f(s0[i]); ps += s0[i]; } \
            l_run += ps; \
            { u32x4 w; w.x = pk2(s0[0], s0[1]); w.y = pk2(s0[2], s0[3]); w.z = pk2(s0[4], s0[5]); w.w = pk2(s0[6], s0[7]); pf[0] = __builtin_bit_cast(bf16x8, w); \
              w.x = pk2(s0[8], s0[9]); w.y = pk2(s0[10], s0[11]); w.z = pk2(s0[12], s0[13]); w.w = pk2(s0[14], s0[15]); pf[1] = __builtin_bit_cast(bf16x8, w); } \
            s1k = s1; \
        } } while (0)
#define AT_PV(te, sl) do { if (pact) { \
            const LAS unsigned char* vb = lds + AT_V0 + (sl) * AT_VB; \
            bf16x8 vfa[NV][2]; \
            _Pragma("unroll") for (int v = 0; v < NV; ++v) { vfa[v][0] = *(const LAS bf16x8*)(vb + 32 * 128 * v + voff[0]); vfa[v][1] = *(const LAS bf16x8*)(vb + 32 * 128 * v + voff[1]); } \
            __builtin_amdgcn_sched_barrier(0); \
            __builtin_amdgcn_s_setprio(1); \
            _Pragma("unroll") for (int v = 0; v < NV; ++v) { o[v] = __builtin_amdgcn_mfma_f32_32x32x16_bf16(vfa[v][0], pf[0], o[v], 0, 0, 0); o[v] = __builtin_amdgcn_mfma_f32_32x32x16_bf16(vfa[v][1], pf[1], o[v], 0, 0, 0); } \
            __builtin_amdgcn_s_setprio(0); \
            __builtin_amdgcn_sched_barrier(0); \
            _Pragma("unroll") for (int v = 0; v < NV; ++v) { vfa[v][0] = *(const LAS bf16x8*)(vb + 32 * 128 * v + voff[2]); vfa[v][1] = *(const LAS bf16x8*)(vb + 32 * 128 * v + voff[3]); } \
            bf16x8 pf2, pf3; \
            { float ps = 0.f; \
              _Pragma("unroll") for (int i = 0; i < 16; ++i) { s1k[i] = __builtin_amdgcn_exp2f(s1k[i]); ps += s1k[i]; } \
              l_run += ps; \
              u32x4 w; w.x = pk2(s1k[0], s1k[1]); w.y = pk2(s1k[2], s1k[3]); w.z = pk2(s1k[4], s1k[5]); w.w = pk2(s1k[6], s1k[7]); pf2 = __builtin_bit_cast(bf16x8, w); \
              w.x = pk2(s1k[8], s1k[9]); w.y = pk2(s1k[10], s1k[11]); w.z = pk2(s1k[12], s1k[13]); w.w = pk2(s1k[14], s1k[15]); pf3 = __builtin_bit_cast(bf16x8, w); } \
            __builtin_amdgcn_sched_barrier(0); \
            __builtin_amdgcn_s_setprio(1); \
            _Pragma("unroll") for (int v = 0; v < NV; ++v) { o[v] = __builtin_amdgcn_mfma_f32_32x32x16_bf16(vfa[v][0], pf2, o[v], 0, 0, 0); o[v] = __builtin_amdgcn_mfma_f32_32x32x16_bf16(vfa[v][1], pf3, o[v], 0, 0, 0); } \
            __builtin_amdgcn_s_setprio(0); \
            __builtin_amdgcn_sched_barrier(0); \
        } } while (0)
        int k0_ = 0, k1_ = 1, k2_ = 2;
        AT_LOADK(0, 0); AT_LOADV(0, 0); AT_LOADK(1, 1); AT_LOADV(1, 1); AT_VMW(NKL + NVL); AT_BAR();
        if (grp == 0) {
            for (int t = 0; t < nt; ++t) {
                const bool deep = t + 2 < nt;
                if (deep) { AT_LOADK(t + 2, k2_); AT_LOADV(t + 2, (t + 2) & 3); }
                AT_QKS(t, k0_);
                AT_PV(t, t & 3);
                if (deep) AT_VMW(NKL + NVL); else AT_VMW(0);
                AT_BAR();
                { const int r_ = k0_; k0_ = k1_; k1_ = k2_; k2_ = r_; }
            }
            AT_BAR();
        } else {
            { const bool deep = 2 < nt; if (deep) { AT_LOADK(2, k2_); AT_LOADV(2, 2); }
              AT_QKS(0, k0_);
              if (deep) AT_VMW(NKL + NVL); else AT_VMW(0);
              AT_BAR();
              { const int r_ = k0_; k0_ = k1_; k1_ = k2_; k2_ = r_; } }
            for (int t = 1; t < nt; ++t) {
                const bool deep = t + 2 < nt;
                if (deep) { AT_LOADK(t + 2, k2_); AT_LOADV(t + 2, (t + 2) & 3); }
                AT_PV(t - 1, (t - 1) & 3);
                AT_QKS(t, k0_);
                if (deep) AT_VMW(NKL + NVL); else AT_VMW(0);
                AT_BAR();
                { const int r_ = k0_; k0_ = k1_; k1_ = k2_; k2_ = r_; }
            }
            AT_PV(nt - 1, (nt - 1) & 3);
            AT_BAR();
        }
        const float lt = l_run + xor32(l_run, hh); const float inv = 1.f / lt;
        bf16* op = O + (size_t)(mqw + r32) * ldo + hq * DV + 8 * hh;
#pragma unroll
        for (int v = 0; v < NV; ++v)
#pragma unroll
            for (int g = 0; g < 4; g += 2) {
                unsigned ax = pk2(o[v][4 * g] * inv, o[v][4 * g + 1] * inv), ay = pk2(o[v][4 * g + 2] * inv, o[v][4 * g + 3] * inv);
                unsigned bx = pk2(o[v][4 * g + 4] * inv, o[v][4 * g + 5] * inv), by = pk2(o[v][4 * g + 6] * inv, o[v][4 * g + 7] * inv);
                auto r0 = __builtin_amdgcn_permlane32_swap(ax, bx, false, false); auto r1 = __builtin_amdgcn_permlane32_swap(ay, by, false, false);
                u32x4 w; w.x = r0[0]; w.y = r1[0]; w.z = r0[1]; w.w = r1[1];
                *(u32x4*)(op + 32 * v + 8 * g) = w; }
#undef AT_M0
#undef AT_LOADK
#undef AT_LOADV
#undef AT_DMA
#undef AT_VMW
#undef AT_QKS
#undef AT_PV
    }
}
__device__ __forceinline__ void post_pass(int gw, int ngw, int lane, const bf16* __restrict__ Y, const float* __restrict__ gY, const float* __restrict__ modsY, int gate_idx,
                                          const float* hin_lat, const float* hin_ctx, float* hout_lat, float* hout_ctx,
                                          bf16* __restrict__ U, const float* __restrict__ gU, const float* __restrict__ modsU, int shift_idx, int scale_idx, int nrows,
                                          const bf16* __restrict__ Yp = nullptr, int nparts = 0, int row_begin = 0) {
    float eps_ = EPS; asm volatile("" : "+v"(eps_));
    for (int r = row_begin + gw; r < nrows; r += ngw) {
        const bool lat = r < TL; const int mb = lat ? (r >> 12) : 8;
        const float* hi_ = lat ? hin_lat + (size_t)r * D : hin_ctx + (size_t)(r - TL) * D;
        f32x4 h[4];
#pragma unroll
        for (int j = 0; j < 4; ++j) h[j] = *(const f32x4*)(hi_ + 256 * j + 4 * lane);
        if (Y) {
            f32x4 y[4]; float ss = 0.f;
            if (Yp && !lat) {
#pragma unroll
                for (int j = 0; j < 4; ++j) y[j] = (f32x4){0.f, 0.f, 0.f, 0.f};
                for (int k = 0; k < nparts; ++k) { const bf16* yr = Yp + ((size_t)k * TC + (r - TL)) * D;
#pragma unroll
                    for (int j = 0; j < 4; ++j) { const u32x2 w = *(const u32x2*)(yr + 256 * j + 4 * lane); y[j] = y[j] + (f32x4){bflo(w.x), bfhi(w.x), bflo(w.y), bfhi(w.y)}; } }
            } else { const bf16* yr = Y + (size_t)r * D;
#pragma unroll
                for (int j = 0; j < 4; ++j) { const u32x2 w = *(const u32x2*)(yr + 256 * j + 4 * lane); y[j] = (f32x4){bflo(w.x), bfhi(w.x), bflo(w.y), bfhi(w.y)}; } }
#pragma unroll
            for (int j = 0; j < 4; ++j) ss += (y[j][0] * y[j][0] + y[j][1] * y[j][1]) + (y[j][2] * y[j][2] + y[j][3] * y[j][3]);
            const float rs = rsqrtf(wave_sum(ss, lane) * (1.f / D) + eps_);
            const float* gt = modsY + (size_t)mb * 6144 + gate_idx * D;
            float* ho = lat ? hout_lat + (size_t)r * D : hout_ctx + (size_t)(r - TL) * D;
#pragma unroll
            for (int j = 0; j < 4; ++j) { const f32x4 g = *(const f32x4*)(gY + 256 * j + 4 * lane); const f32x4 ga = *(const f32x4*)(gt + 256 * j + 4 * lane);
                h[j] = h[j] + ga * (y[j] * rs * g); *(f32x4*)(ho + 256 * j + 4 * lane) = h[j]; }
        }
        if (U) {
            float ss = 0.f;
#pragma unroll
            for (int j = 0; j < 4; ++j) ss += (h[j][0] * h[j][0] + h[j][1] * h[j][1]) + (h[j][2] * h[j][2] + h[j][3] * h[j][3]);
            const float rs = rsqrtf(wave_sum(ss, lane) * (1.f / D) + eps_);
            const float* sh = modsU + (size_t)mb * 6144 + shift_idx * D; const float* sc = modsU + (size_t)mb * 6144 + scale_idx * D;
            bf16* ur = U + (size_t)r * D;
#pragma unroll
            for (int j = 0; j < 4; ++j) { const f32x4 g = *(const f32x4*)(gU + 256 * j + 4 * lane); const f32x4 s1 = *(const f32x4*)(sc + 256 * j + 4 * lane); const f32x4 s0 = *(const f32x4*)(sh + 256 * j + 4 * lane);
                const f32x4 v = (h[j] * rs * g) * (s1 + 1.f) + s0; u32x2 w; w.x = pk2(v[0], v[1]); w.y = pk2(v[2], v[3]); *(u32x2*)(ur + 256 * j + 4 * lane) = w; }
        }
    }
}
__device__ __forceinline__ void diff_combine(int gw, int ngw, int lane, const bf16* __restrict__ OB, bf16* __restrict__ ATT, const float* __restrict__ lam, const float* __restrict__ subln, float lam_init) {
    const float p1 = wave_sum(lam[lane] * lam[64 + lane], lane), p2 = wave_sum(lam[128 + lane] * lam[192 + lane], lane);
    const float lam_full = expf(p1) - expf(p2) + lam_init;
    const int hd = lane >> 3, j0 = (lane & 7) * 16;
    float g[16];
#pragma unroll
    for (int e = 0; e < 16; ++e) g[e] = subln[j0 + e] * (1.f - lam_init);
    for (int r = gw; r < MT; r += ngw) {
        const bf16* p = OB + (size_t)r * 2048 + hd * 256 + j0;
        const u32x4 a0 = *(const u32x4*)p, a1 = *(const u32x4*)(p + 8), b0 = *(const u32x4*)(p + 128), b1 = *(const u32x4*)(p + 136);
        const unsigned aw[8] = {a0.x, a0.y, a0.z, a0.w, a1.x, a1.y, a1.z, a1.w}, bw[8] = {b0.x, b0.y, b0.z, b0.w, b1.x, b1.y, b1.z, b1.w};
        float o[16]; float ss = 0.f;
#pragma unroll
        for (int e = 0; e < 8; ++e) { o[2 * e] = bflo(aw[e]) - lam_full * bflo(bw[e]); o[2 * e + 1] = bfhi(aw[e]) - lam_full * bfhi(bw[e]); ss += o[2 * e] * o[2 * e] + o[2 * e + 1] * o[2 * e + 1]; }
        ss += shx(ss, 1, lane); ss += shx(ss, 2, lane); ss += shx(ss, 4, lane);
        const float rs = rsqrtf(ss * (1.f / 128.f) + EPS);
        u32x4 w0, w1;
        w0.x = pk2(o[0] * rs * g[0], o[1] * rs * g[1]); w0.y = pk2(o[2] * rs * g[2], o[3] * rs * g[3]); w0.z = pk2(o[4] * rs * g[4], o[5] * rs * g[5]); w0.w = pk2(o[6] * rs * g[6], o[7] * rs * g[7]);
        w1.x = pk2(o[8] * rs * g[8], o[9] * rs * g[9]); w1.y = pk2(o[10] * rs * g[10], o[11] * rs * g[11]); w1.z = pk2(o[12] * rs * g[12], o[13] * rs * g[13]); w1.w = pk2(o[14] * rs * g[14], o[15] * rs * g[15]);
        bf16* q = ATT + (size_t)r * D + hd * 128 + j0; *(u32x4*)q = w0; *(u32x4*)(q + 8) = w1;
    }
}
__device__ __forceinline__ void mla_norm(int gw, int ngw, int lane, bf16* __restrict__ CQ, bf16* __restrict__ KR, const float* __restrict__ qn, const float* __restrict__ kvn, const float* __restrict__ tab32) {
    for (int r = gw; r < MT; r += ngw) {
        bf16* row = CQ + (size_t)r * 768;
        unsigned* cq = (unsigned*)(row + 6 * lane); unsigned a0 = cq[0], a1 = cq[1], a2 = cq[2];
        float x[6] = {bflo(a0), bfhi(a0), bflo(a1), bfhi(a1), bflo(a2), bfhi(a2)}; float ss = 0.f;
#pragma unroll
        for (int e = 0; e < 6; ++e) ss += x[e] * x[e];
        float rs = rsqrtf(wave_sum(ss, lane) * (1.f / 384.f) + EPS);
#pragma unroll
        for (int e = 0; e < 6; ++e) x[e] = x[e] * rs * qn[6 * lane + e];
        cq[0] = pk2(x[0], x[1]); cq[1] = pk2(x[2], x[3]); cq[2] = pk2(x[4], x[5]);
        u32x2* ck = (u32x2*)(row + 384 + 4 * lane); u32x2 b = *ck; float y[4] = {bflo(b.x), bfhi(b.x), bflo(b.y), bfhi(b.y)};
        ss = y[0] * y[0] + y[1] * y[1] + y[2] * y[2] + y[3] * y[3];
        rs = rsqrtf(wave_sum(ss, lane) * (1.f / 256.f) + EPS);
#pragma unroll
        for (int e = 0; e < 4; ++e) y[e] = y[e] * rs * kvn[4 * lane + e];
        b.x = pk2(y[0], y[1]); b.y = pk2(y[2], y[3]); *ck = b;
        const int l = lane & 31; const float v = __uint_as_float((unsigned)row[640 + l] << 16);
        const float p = shx(v, 8, lane);
        float outv = v;
        if (r < TL) { const int s = r & 4095; const int pos = (l & 16) ? (s & 63) : (s >> 6); const float cs = tab32[(pos * 8 + (l & 7)) * 2], sn = tab32[(pos * 8 + (l & 7)) * 2 + 1];
            outv = (l & 8) ? v * cs + p * sn : v * cs - p * sn; }
        const float nb = shx(outv, 1, lane);
        if (lane < 32 && !(lane & 1)) *(unsigned*)(KR + (size_t)r * 32 + lane) = pk2(outv, nb);
    }
}
__device__ __forceinline__ void conv_tile(LAS float* scr, const float* __restrict__ src, int N, int k0, int c0, bf16* __restrict__ dst, int ldd, int drow0, int tid) {
    const int nn = tid & 63, kq = tid >> 6;
#pragma unroll
    for (int i = 0; i < 8; ++i) { const int kk = kq + 8 * i; scr[kk * 65 + nn] = (c0 + nn < N) ? src[(size_t)(k0 + kk) * N + c0 + nn] : 0.f; }
    __syncthreads();
    const int n = tid >> 3, kc = tid & 7; const LAS float* s = scr + (8 * kc) * 65 + n;
    u32x4 o; o.x = pk2(s[0], s[65]); o.y = pk2(s[2 * 65], s[3 * 65]); o.z = pk2(s[4 * 65], s[5 * 65]); o.w = pk2(s[6 * 65], s[7 * 65]);
    *(u32x4*)(dst + (size_t)(drow0 + n) * ldd + k0 + 8 * kc) = o;
    __syncthreads();
}
__device__ __forceinline__ void conv_layer(LAS unsigned char* lds, const LayerPtrs& L, int kind, bf16* W, int tid) {
    LAS float* scr = (LAS float*)lds;
    bf16* mix = W + WO_MIX;
    const int n_w1 = 16 * 64, n_w2 = 64 * 16, n_wo = 16 * 16;
    int n_a, n_uq = 0, n_ukv = 0;
    if (kind == 0) n_a = 16 * 24; else if (kind == 1) n_a = 16 * 48; else { n_a = 16 * 12; n_uq = 6 * 24; n_ukv = 4 * 32; }
    const int total = n_w1 + n_w2 + n_wo + n_a + n_uq + n_ukv;
    const int nn = tid & 63, kq = tid >> 6;
#define CJ_DECODE(r_in, SRC, NN, K0, C0, DST, LDD, DR0) do { int r = (r_in); \
        if (r < n_w1) { SRC = L.w1; NN = FF; K0 = (r / 64) * 64; C0 = (r % 64) * 64; DST = W + WO_W1; LDD = D; DR0 = (r % 64) * 64; } \
        else if ((r -= n_w1) < n_w2) { SRC = L.w2; NN = D; K0 = (r / 16) * 64; C0 = (r % 16) * 64; DST = W + WO_W2; LDD = FF; DR0 = (r % 16) * 64; } \
        else if ((r -= n_w2) < n_wo) { SRC = L.w_o; NN = D; K0 = (r / 16) * 64; C0 = (r % 16) * 64; DST = W + WO_WO; LDD = D; DR0 = (r % 16) * 64; } \
        else if ((r -= n_wo) < n_a) { SRC = L.w_a; LDD = D; \
            if (kind == 0) { const int kt = r / 24, tn = r % 24; NN = 1536; K0 = kt * 64; C0 = tn * 64; DST = tn < 20 ? mix : mix + (size_t)1280 * D; DR0 = tn < 20 ? tn * 64 : (tn - 20) * 64; } \
            else if (kind == 1) { const int kt = r / 48, tn = r % 48; NN = 3072; K0 = kt * 64; C0 = tn * 64; DST = tn < 32 ? mix : mix + (size_t)2048 * D; DR0 = tn < 32 ? tn * 64 : (tn - 32) * 64; } \
            else { const int kt = r / 12, tn = r % 12; NN = 672; K0 = kt * 64; C0 = tn * 64; DST = mix; DR0 = tn * 64; } } \
        else if ((r -= n_a) < n_uq) { const int kt = r / 24, tn = r % 24; SRC = L.w_uq; NN = 1536; K0 = kt * 64; C0 = tn * 64; DST = mix + (size_t)768 * D; LDD = 384; DR0 = tn * 64; } \
        else { r -= n_uq; const int kt = r / 32, tn = r % 32; SRC = L.w_ukv; NN = 2048; K0 = kt * 64; C0 = tn * 64; \
               DST = mix + (size_t)768 * D + (size_t)1536 * 384 + ((tn & 1) ? (size_t)1024 * 256 : 0); LDD = 256; DR0 = (tn >> 1) * 64; } } while (0)
#define CJ_LOAD(V, SRC, NN, K0, C0) do { _Pragma("unroll") for (int i = 0; i < 8; ++i) V[i] = ((C0) + nn < (NN)) ? (SRC)[(size_t)((K0) + kq + 8 * i) * (NN) + (C0) + nn] : 0.f; } while (0)
    int bid_ = blockIdx.x; asm volatile("" : "+s"(bid_));
    const int gsz = gridDim.x;
    int it = bid_;
    const float* src = nullptr; int N = 0, k0 = 0, c0 = 0, ldd = 0, drow0 = 0; bf16* dst = nullptr;
    float v[8];
    if (it < total) { CJ_DECODE(it, src, N, k0, c0, dst, ldd, drow0); CJ_LOAD(v, src, N, k0, c0); }
    while (it < total) {
#pragma unroll
        for (int i = 0; i < 8; ++i) scr[(kq + 8 * i) * 65 + nn] = v[i];
        const int itn = it + gsz;
        const float* srcn = nullptr; int Nn = 0, k0n = 0, c0n = 0, lddn = 0, drow0n = 0; bf16* dstn = nullptr;
        if (itn < total) { CJ_DECODE(itn, srcn, Nn, k0n, c0n, dstn, lddn, drow0n); CJ_LOAD(v, srcn, Nn, k0n, c0n); }
        __syncthreads();
        { const int n = tid >> 3, kc = tid & 7; const LAS float* sp = scr + (8 * kc) * 65 + n;
          u32x4 o; o.x = pk2(sp[0], sp[65]); o.y = pk2(sp[2 * 65], sp[3 * 65]); o.z = pk2(sp[4 * 65], sp[5 * 65]); o.w = pk2(sp[6 * 65], sp[7 * 65]);
          *(u32x4*)(dst + (size_t)(drow0 + n) * ldd + k0 + 8 * kc) = o; }
        __syncthreads();
        it = itn; src = srcn; N = Nn; k0 = k0n; c0 = c0n; dst = dstn; ldd = lddn; drow0 = drow0n;
    }
#undef CJ_DECODE
#undef CJ_LOAD
}
__device__ __forceinline__ void mods_phase(LAS unsigned char* lds, const Params& p, float* mods, int tid) {
    LAS float* sc = (LAS float*)lds;
    LAS float* red = (LAS float*)(lds + 9 * 1024 * 4);
    for (int idx = tid; idx < 9 * 1024; idx += NTHREADS) { const int bb = idx >> 10, k = idx & 1023; const float v = bb < 8 ? p.c[bb * 1024 + k] : p.c_ctx[k]; sc[idx] = v / (1.f + __expf(-v)); }
    __syncthreads();
    const int col = tid & 63, kg = tid >> 6;
    int bid_ = blockIdx.x; asm volatile("" : "+s"(bid_));
    for (int it = bid_; it < 4 * 96; it += gridDim.x) {
        const int l = it / 96, n0 = (it % 96) * 64;
        const float* aw = p.L[l].ada_w; const float* ab = p.L[l].ada_b;
        float acc[9];
#pragma unroll
        for (int bb = 0; bb < 9; ++bb) acc[bb] = 0.f;
        const float* wp = aw + (size_t)(kg * 128) * 6144 + n0 + col;
#pragma unroll 32
        for (int k = 0; k < 128; ++k) { const float w = wp[(size_t)k * 6144];
#pragma unroll
            for (int bb = 0; bb < 9; ++bb) acc[bb] += sc[bb * 1024 + kg * 128 + k] * w; }
#pragma unroll
        for (int bb = 0; bb < 9; ++bb) red[(kg * 9 + bb) * 64 + col] = acc[bb];
        __syncthreads();
        for (int o = tid; o < 576; o += NTHREADS) { const int bb = o >> 6, c = o & 63; float s = 0.f;
#pragma unroll
            for (int g = 0; g < 8; ++g) s += red[(g * 9 + bb) * 64 + c];
            mods[(size_t)l * MODS_PER_LAYER + bb * 6144 + n0 + c] = s + ab[n0 + c]; }
        __syncthreads();
    }
}
__device__ __forceinline__ void tables_phase(float* tab64, float* tab32) {
    const int g = blockIdx.x * NTHREADS + threadIdx.x;
    if (g < 1024) { const int pos = g >> 4, i = g & 15; const float inv = powf(10000.f, -(float)i / 16.f); const float a = (float)pos * inv; tab64[2 * g] = cosf(a); tab64[2 * g + 1] = sinf(a); }
    else if (g < 1536) { const int h = g - 1024; const int pos = h >> 3, i = h & 7; const float inv = powf(10000.f, -(float)i / 8.f); const float a = (float)pos * inv; tab32[2 * h] = cosf(a); tab32[2 * h + 1] = sinf(a); }
}

constexpr int REP_A = 1, REP_B = 1, REP_C = 1, REP_MLP = 1, REP_SYNC = 0, REP_P1 = 1, REP_P0 = 1;
template <class Epi> __device__ __forceinline__ void run_gemm(LAS unsigned char* lds, const bf16* A, int lda, const bf16* Bt, int ldb, int M, int N, int K, const Epi& E, int cidx = -1) {
    pg8::Gemm g{A, Bt, M, N, K, lda, ldb}; int bid_ = blockIdx.x, gd_ = gridDim.x; asm volatile("" : "+s"(bid_), "+s"(gd_)); pg8::StaticOrder S; S.init(M, N, gd_, cidx >= 0 ? cidx : bid_);
    pg8::gemm_phase<Epi, pg8::StaticOrder, true, true>((PG8_LAS unsigned char*)lds, g, S, E);
}

__global__ void __launch_bounds__(NTHREADS, 2) fwd_megakernel(Params p) {
    extern __shared__ __attribute__((aligned(16))) unsigned char lds_raw[];
    LAS unsigned char* lds = (LAS unsigned char*)lds_raw;
    cg::grid_group grid = cg::this_grid();
    volatile LAS unsigned* xb_st = (volatile LAS unsigned*)(lds + 139264);
    if (threadIdx.x == 0) { xb_st[0] = 0u; xb_st[1] = 0u; }
    __syncthreads();
    (void)xcd_barrier_post((unsigned*)(p.ws + WS_XBAR), xb_st);
#define GSYNC() do { size_t zb_ = 0; asm volatile("" : "+s"(zb_)); XcdBarrier xb_; xb_.bar = (unsigned*)(p.ws + WS_XBAR + zb_); xb_.x = xb_xcc_id(); xb_.st = (volatile LAS unsigned*)(lds + 139264); xcd_barrier(xb_); } while (0)
    int tid, lane, wave, gw; const int ngw = gridDim.x * NWAVES;
#define FRESH() do { int t_ = threadIdx.x; asm volatile("" : "+v"(t_)); tid = t_; lane = tid & 63; wave = __builtin_amdgcn_readfirstlane(tid >> 6); int b_ = blockIdx.x; asm volatile("" : "+s"(b_)); gw = b_ * NWAVES + wave; } while (0)
#define DERIVE() size_t z_ = 0; asm volatile("" : "+s"(z_)); unsigned char* ws = p.ws + z_; \
    float* tab64 = (float*)(ws + WS_TAB); float* tab32 = (float*)(ws + WS_TAB + 8192); float* mods = (float*)(ws + WS_MODS); float* HC = (float*)(ws + WS_HC); \
    bf16* KR = (bf16*)(ws + WS_KR); bf16* U = (bf16*)(ws + WS_U); bf16* Y = (bf16*)(ws + WS_Y); bf16* BIG = (bf16*)(ws + WS_BIG); \
    (void)tab64; (void)tab32; (void)mods; (void)HC; (void)KR; (void)U; (void)Y; (void)BIG
#define DERIVE_L() DERIVE(); bf16* W = (bf16*)(ws + WS_W + (size_t)(l & 1) * WS_WSTRIDE); bf16* mix = W + WO_MIX; const float* modsl = mods + (size_t)l * MODS_PER_LAYER; (void)mix; (void)modsl
    FRESH();
    for (int rep = 0; rep < REP_P0; ++rep) { DERIVE();
      tables_phase(tab64, tab32);
      mods_phase(lds, p, mods, tid);
      conv_layer(lds, p.L[0], 0, (bf16*)(ws + WS_W), tid); }
    if (p.ws == nullptr) grid.sync();
    GSYNC(); FRESH();
    for (int rep = 0; rep < REP_SYNC; ++rep) GSYNC();
    for (int rep = 0; rep < REP_P1; ++rep) { DERIVE(); post_pass(gw, ngw, lane, nullptr, nullptr, nullptr, 0, p.x, p.ctx, nullptr, nullptr, U, p.L[0].norms, mods, 0, 1, MT); }
    GSYNC(); FRESH();

#pragma unroll 1
    for (int l = 0; l < 4; ++l) {
        const int kind = l % 3;
        if (kind == 0) {
            { DERIVE_L(); bf16* Qb = BIG; bf16* Kb = BIG + (size_t)MT * 1024; bf16* Vt = Kb + (size_t)MT * 256;
              { pg8::EpiRope<0> E{Qb, 1024, 1024, Kb, 256, 0.125f * LOG2E, tab64, TL}; run_gemm(lds, U, D, mix, D, MT, 1280, D, E); }
              { pg8::EpiStore E{Vt, MT, 0, nullptr, 0, 0}; run_gemm(lds, mix + (size_t)1280 * D, D, U, D, 256, MT, D, E); } }
            GSYNC(); FRESH();
            { DERIVE_L(); bf16* Qb = BIG; bf16* Kb = BIG + (size_t)MT * 1024; bf16* Vt = Kb + (size_t)MT * 256;
              for (int rep = 0; rep < REP_A; ++rep) attn_phase<64, 64, true, true>(lds, Qb, 1024, Kb, 256, 2, nullptr, Vt, 2, U, 1024, p.L[l].x0, 2048, 128); }
            GSYNC(); FRESH();
        } else if (kind == 1) {
            { DERIVE_L(); bf16* Qb = BIG; bf16* Kb = BIG + (size_t)MT * 1024; bf16* Vt = Kb + (size_t)MT * 1024;
              { pg8::EpiRope<0> E{Qb, 1024, 1024, Kb, 1024, 0.125f * LOG2E, tab64, TL}; run_gemm(lds, U, D, mix, D, MT, 2048, D, E); }
              { pg8::EpiStore E{Vt, MT, 0, nullptr, 0, 0}; run_gemm(lds, mix + (size_t)2048 * D, D, U, D, 1024, MT, D, E, (int)((blockIdx.x + 256 - 64) & 255)); } }
            GSYNC(); FRESH();
            { DERIVE_L(); bf16* Qb = BIG; bf16* Kb = BIG + (size_t)MT * 1024; bf16* Vt = Kb + (size_t)MT * 1024;
              for (int rep = 0; rep < REP_B; ++rep) attn_phase<64, 128, false>(lds, Qb, 1024, Kb, 1024, 0, nullptr, Vt, 1, U  , 2048, nullptr, 2048, 128); }
            GSYNC(); FRESH();
            { DERIVE_L(); diff_combine(gw, ngw, lane, U, BIG, p.L[l].x0, p.L[l].x1, 0.8f - 0.6f * 0.7408182206817179f); }
            GSYNC(); FRESH();
        } else {
            { DERIVE_L(); pg8::EpiStore E{Y, 768, 0, nullptr, 0, 0}; run_gemm(lds, U, D, mix, D, MT, 768, D, E); }
            GSYNC(); FRESH();
            { DERIVE_L(); mla_norm(gw, ngw, lane, Y, KR, p.L[l].x0, p.L[l].x1, tab32); }
            GSYNC(); FRESH();
            { DERIVE_L(); bf16* CQ = Y; bf16* Qb = BIG; bf16* Kn = BIG + (size_t)MT * 1536; bf16* Vt = Kn + (size_t)MT * 1024;
              const bf16* Wuq = mix + (size_t)768 * D; const bf16* Wkn = Wuq + (size_t)1536 * 384; const bf16* Wv = Wkn + (size_t)1024 * 256;
              { pg8::EpiRope<1> E{Qb, 1536, 0, nullptr, 0, 0.10206207261596575f * LOG2E, tab32, TL}; run_gemm(lds, CQ, 768, Wuq, 384, MT, 1536, 384, E); }
              { pg8::EpiStore E{Kn, 1024, 0, nullptr, 0, 0}; run_gemm(lds, CQ + 384, 768, Wkn, 256, MT, 1024, 256, E, (int)((blockIdx.x + 256 - 48) & 255)); }
              { pg8::EpiStore E{Vt, MT, 0, nullptr, 0, 0}; run_gemm(lds, Wv, 256, CQ + 384, 768, 1024, MT, 256, E, (int)((blockIdx.x + 256 - 80) & 255)); } }
            GSYNC(); FRESH();
            { DERIVE_L(); bf16* Qb = BIG; bf16* Kn = BIG + (size_t)MT * 1536; bf16* Vt = Kn + (size_t)MT * 1024;
              for (int rep = 0; rep < REP_C; ++rep) attn_phase<96, 64, false>(lds, Qb, 1536, Kn, 1024, 0, KR, Vt, 0, U, 1024, nullptr, 2048, 128); }
            GSYNC(); FRESH();
        }
        { DERIVE_L(); const bf16* attn_out = (kind == 1) ? BIG : U; const float* nr = p.L[l].norms;
          { pg8::EpiFuse E{(l == 0) ? p.x : p.out, p.out, U, nr + D, modsl + 2 * D, nr + 2 * D, modsl + 4 * D, modsl + 3 * D,
                           (float*)(ws + WS_XBUF), (unsigned*)(ws + WS_XCNT), 16u * (unsigned)(2 * (2 * l) + 1), (PG8_LAS unsigned char*)(lds + 131072), EPS};
            run_gemm(lds, attn_out, D, W + WO_WO, D, TL, D, D, E); }
          if (l < 3) {
              int kc = blockIdx.x >> 5; asm volatile("" : "+s"(kc)); const int kcc = kc < 4 ? kc : 0;
              pg8::EpiStore E{(bf16*)(ws + WS_YP) + (size_t)kcc * TC * D, D, 0, nullptr, 0, 0};
              run_gemm(lds, attn_out + (size_t)TL * D + kcc * 256, D, W + WO_WO + kcc * 256, D, TC, D, 256, E, kc < 4 ? (int)(blockIdx.x & 31) : (1 << 20)); } }
        GSYNC(); FRESH();
        if (l < 3) {
            { DERIVE_L(); const float* nr = p.L[l].norms;
              post_pass(gw, ngw, lane, Y, nr + D, modsl, 2, p.out, (l == 0) ? p.ctx : HC, p.out, HC, U, nr + 2 * D, modsl, 3, 4, MT, (const bf16*)(ws + WS_YP), 4, TL); }
            GSYNC(); FRESH();
        }
        { DERIVE_L(); pg8::EpiStore E{BIG, FF, 0, nullptr, 0, 1}; run_gemm(lds, U, D, W + WO_W1, D, l < 3 ? MT : TL, FF, D, E); }
        GSYNC(); FRESH();
        { DERIVE_L(); const int ln_ = l < 3 ? l + 1 : l;
          { pg8::EpiFuse E{p.out, p.out, l < 3 ? U : nullptr, p.L[l].norms + 3 * D, modsl + 5 * D, p.L[ln_].norms, modsl + MODS_PER_LAYER + 1 * D, modsl + MODS_PER_LAYER,
                           (float*)(ws + WS_XBUF), (unsigned*)(ws + WS_XCNT), 16u * (unsigned)(2 * (2 * l + 1) + 1), (PG8_LAS unsigned char*)(lds + 131072), EPS};
            run_gemm(lds, BIG, FF, W + WO_W2, FF, TL, D, FF, E); }
          if (l < 3) {
              int kc = blockIdx.x >> 5; asm volatile("" : "+s"(kc)); const int kcc = kc & 7;
              pg8::EpiStore E{(bf16*)(ws + WS_YP) + (size_t)kcc * TC * D, D, 0, nullptr, 0, 0};
              run_gemm(lds, BIG + (size_t)TL * FF + kcc * 512, FF, W + WO_W2 + kcc * 512, FF, TC, D, 512, E, (int)(blockIdx.x & 31)); } }
        if (l < 3) {
            GSYNC(); FRESH();
            { DERIVE_L(); post_pass(gw, ngw, lane, Y, p.L[l].norms + 3 * D, modsl, 5, p.out, HC, p.out, HC, U, p.L[l + 1].norms, modsl + MODS_PER_LAYER, 0, 1, MT, (const bf16*)(ws + WS_YP), 8, TL);
              conv_layer(lds, p.L[l + 1], (l + 1) % 3, (bf16*)(ws + WS_W + (size_t)((l + 1) & 1) * WS_WSTRIDE), tid); }
            GSYNC(); FRESH();
        }
    }
}

extern "C" void kernel_launch(void* const* d_in, const int* in_sizes, int n_in, void* d_out, int out_size, void* d_ws, size_t ws_size, hipStream_t stream) {
    static int grid = 0;
    if (grid == 0) {
        if (n_in != 40 || ws_size < WS_END || out_size != TL * D) { fprintf(stderr, "kernel_launch: unexpected shapes n_in %d ws %zu out %d\n", n_in, ws_size, out_size); grid = -1; return; }
        int dev = 0, cus = 0, per_cu = 0;
        hipGetDevice(&dev); hipDeviceGetAttribute(&cus, hipDeviceAttributeMultiprocessorCount, dev);
        if (hipFuncSetAttribute((const void*)fwd_megakernel, hipFuncAttributeMaxDynamicSharedMemorySize, LDS_BYTES) != hipSuccess) { fprintf(stderr, "hipFuncSetAttribute failed\n"); grid = -1; return; }
        if (hipOccupancyMaxActiveBlocksPerMultiprocessor(&per_cu, (const void*)fwd_megakernel, NTHREADS, LDS_BYTES) != hipSuccess || per_cu < 1) { fprintf(stderr, "occupancy query: %d\n", per_cu); per_cu = 1; }
        (void)hipGetLastError();
        grid = cus * 1;
    }
    if (grid < 0) return;
    Params p{};
    p.x = (const float*)d_in[0]; p.c = (const float*)d_in[1]; p.ctx = (const float*)d_in[2]; p.c_ctx = (const float*)d_in[3];
    p.out = (float*)d_out; p.ws = (unsigned char*)d_ws;
    auto F = [&](int i) { return (const float*)d_in[i]; };
    p.L[0] = LayerPtrs{F(4), F(5), F(6), F(7), F(9), F(10), F(11), F(8), nullptr, nullptr, nullptr};
    p.L[1] = LayerPtrs{F(12), F(13), F(14), F(15), F(18), F(19), F(20), F(16), F(17), nullptr, nullptr};
    p.L[2] = LayerPtrs{F(21), F(22), F(23), F(24), F(29), F(30), F(31), F(25), F(26), F(27), F(28)};
    p.L[3] = LayerPtrs{F(32), F(33), F(34), F(35), F(37), F(38), F(39), F(36), nullptr, nullptr, nullptr};
    (void)hipMemsetAsync((char*)d_ws + WS_XBAR, 0, WS_XCNT + 128 * 256 - WS_XBAR, stream);
    void* args[] = {&p};
    hipError_t e = hipLaunchCooperativeKernel((const void*)fwd_megakernel, dim3(grid), dim3(NTHREADS), args, LDS_BYTES, stream);
    if (e != hipSuccess) fprintf(stderr, "cooperative launch failed: %s (grid %d)\n", hipGetErrorString(e), grid);
}
```

```cpp
#include <hip/hip_runtime.h>
#include <hip/hip_cooperative_groups.h>
#include <cstdio>
#include <cstdint>
namespace cg = cooperative_groups;
namespace pg8 {
#define PG8_LAS __attribute__((address_space(3)))
typedef unsigned short bf16_t;
typedef short bf16x8 __attribute__((ext_vector_type(8)));
typedef float f32x4 __attribute__((ext_vector_type(4)));
typedef unsigned u32x4 __attribute__((ext_vector_type(4)));
constexpr int BM = 256, BK = 64, HALF = 128, HTB = HALF * BK * 2  , STAGE_BYTES = 8 * HTB, NXCD = 8, WGM = 8;

__host__ __device__ __forceinline__ int lds_byte(int r, int c) { const int st = (r >> 4) * 2 + (c >> 5), rr = r & 15, cc = c & 31, ob = rr * 64 + cc * 2; return st * 1024 + (ob ^ (((ob >> 9) & 1) << 5)); }
__host__ __device__ __forceinline__ void stage_rc(int b, int& R, int& C) { const int st = b / 1024, sb = b % 1024, swz = sb ^ (((sb >> 9) & 1) << 5); R = (st >> 1) * 16 + swz / 64; C = (st & 1) * 32 + (swz % 64) / 2; }
__host__ __device__ __forceinline__ int perm32(int rho) { const int n = rho >> 4, i = rho & 15; return 8 * (i >> 2) + 4 * n + (i & 3); }

struct Unit { int pm, pn; };
struct Gemm { const bf16_t* A; const bf16_t* Bt; int M, N, K, lda, ldb; };

struct StaticOrder {
    int nM, nN, nwg, G, c;
    __host__ __device__ void init(int M, int N, int G_, int c_) { nM = M / BM; nN = N / BM; nwg = nM * nN; G = G_; c = c_; }
    __host__ __device__ bool next(int i, Unit& u) const {
        const int L = i * G + c; if (L >= nwg) return false;
        int wgid = L; { const int q = nwg / NXCD, r = nwg % NXCD, xcd = wgid % NXCD, off = wgid / NXCD; wgid = (xcd < r ? xcd * (q + 1) : r * (q + 1) + (xcd - r) * q) + off; }
        const int nig = WGM * nN, gid = wgid / nig, fm = gid * WGM, gsz = (nM - fm) < WGM ? (nM - fm) : WGM;
        u.pm = fm + ((wgid % nig) % gsz); u.pn = (wgid % nig) / gsz; return true;
    }
    __device__ __forceinline__ void a_ready(const Unit&) const {}
    __device__ __forceinline__ void done(const Unit&) const {}
};

__device__ __forceinline__ unsigned cvt_pk_bf16(float lo, float hi) { unsigned r; asm volatile("v_cvt_pk_bf16_f32 %0, %1, %2" : "=v"(r) : "v"(lo), "v"(hi)); return r; }
typedef float f32x2 __attribute__((ext_vector_type(2)));
__device__ __forceinline__ unsigned pk2e(float lo, float hi) { typedef float v2f __attribute__((ext_vector_type(2))); typedef __bf16 v2b __attribute__((ext_vector_type(2))); v2f v = {lo, hi}; v2b b = __builtin_convertvector(v, v2b); return __builtin_bit_cast(unsigned, b); }
struct EpiStore {
    static constexpr bool PERM = true, AFTER_DRAIN = false;
    bf16_t* O0; int ld0; int split_col; bf16_t* O1; int ld1; int act;
    __device__ __forceinline__ void operator()(const f32x4 (&acc)[2][2][4][2], const Unit& u, int wr, int wc, int fr_, int fq_) const {
        int ln_ = threadIdx.x & 63; asm volatile("" : "+v"(ln_)); const int fr = ln_ & 15, fq = ln_ >> 4; (void)fr_; (void)fq_;
        const int row0 = u.pm * BM + wr * 64 + fr; int colt = u.pn * BM; bf16_t* base = O0; int ld = ld0;
        if (split_col && colt >= split_col) { base = O1; ld = ld1; colt -= split_col; }
        const int col0 = colt + wc * 32 + 8 * fq;
#pragma unroll
        for (int ai = 0; ai < 2; ++ai)
#pragma unroll
            for (int m = 0; m < 4; ++m) { bf16_t* rowp = base + (size_t)(row0 + ai * HALF + m * 16) * ld + col0;
#pragma unroll
                for (int bj = 0; bj < 2; ++bj) { f32x4 v0 = acc[ai][bj][m][0], v1 = acc[ai][bj][m][1];
                    if (act) {
#pragma unroll
                        for (int e = 0; e < 4; ++e) { float a = v0[e] > 0.f ? v0[e] : 0.f; v0[e] = a * a; float b = v1[e] > 0.f ? v1[e] : 0.f; v1[e] = b * b; } }
                    u32x4 w; w.x = pk2e(v0[0], v0[1]); w.y = pk2e(v0[2], v0[3]); w.z = pk2e(v1[0], v1[1]); w.w = pk2e(v1[2], v1[3]);
                    *(u32x4*)(rowp + bj * HALF) = w; } }
    }
};
template <int MODE> struct EpiRope {
    static constexpr bool PERM = false, AFTER_DRAIN = false;
    bf16_t* O0; int ld0; int split_col; bf16_t* O1; int ld1; float qscale; const float* tab; int tlat;
    __device__ __forceinline__ void operator()(const f32x4 (&acc)[2][2][4][2], const Unit& u, int wr, int wc, int fr_, int fq_) const {
        int ln_ = threadIdx.x & 63; asm volatile("" : "+v"(ln_)); const int fr = ln_ & 15, fq = ln_ >> 4; (void)fr_; (void)fq_;
        typedef unsigned u32x2v __attribute__((ext_vector_type(2)));
        int colt = u.pn * BM; bf16_t* base = O0; int ld = ld0; float sc = qscale;
        const int gcolt = colt;
        if (split_col && colt >= split_col) { base = O1; ld = ld1; colt -= split_col; sc = 1.f; }
#pragma unroll
        for (int ai = 0; ai < 2; ++ai)
#pragma unroll
            for (int m = 0; m < 4; ++m) {
                const int row = u.pm * BM + ai * HALF + wr * 64 + m * 16 + fr;
                const bool lat = row < tlat; const int s = row & 4095, prow = s >> 6, pcol = s & 63;
                bf16_t* rowp = base + (size_t)row * ld + colt + wc * 32 + 4 * fq;
#pragma unroll
                for (int bj = 0; bj < 2; ++bj) {
                    if (MODE == 0) {
                        const int pos = (wc & 1) ? pcol : prow;
                        const f32x4* tp = (const f32x4*)(tab + (size_t)(pos * 16 + 4 * fq) * 2);
                        const f32x4 t0 = tp[0], t1 = tp[1];
                        const f32x4 x1 = acc[ai][bj][m][0], x2 = acc[ai][bj][m][1];
                        const float cs[4] = {t0[0], t0[2], t1[0], t1[2]}, sn[4] = {t0[1], t0[3], t1[1], t1[3]};
                        float o1[4], o2[4];
#pragma unroll
                        for (int e = 0; e < 4; ++e) { o1[e] = lat ? x1[e] * cs[e] - x2[e] * sn[e] : x1[e]; o2[e] = lat ? x2[e] * cs[e] + x1[e] * sn[e] : x2[e]; o1[e] *= sc; o2[e] *= sc; }
                        u32x2v w1, w2; w1.x = pk2e(o1[0], o1[1]); w1.y = pk2e(o1[2], o1[3]); w2.x = pk2e(o2[0], o2[1]); w2.y = pk2e(o2[2], o2[3]);
                        *(u32x2v*)(rowp + bj * HALF) = w1; *(u32x2v*)(rowp + bj * HALF + 16) = w2;
                    } else {
#pragma unroll
                        for (int n = 0; n < 2; ++n) {
                            const int c0 = gcolt + bj * HALF + wc * 32 + 16 * n; const int cc = c0 % 96;
                            const f32x4 x = acc[ai][bj][m][n]; float o[4] = {x[0], x[1], x[2], x[3]};
                            if (cc >= 64) {
                                const int pos = (cc >= 80) ? pcol : prow;
                                const f32x4* tp = (const f32x4*)(tab + (size_t)(pos * 8 + 4 * (fq & 1)) * 2);
                                const f32x4 t0 = tp[0], t1 = tp[1];
                                const float cs[4] = {t0[0], t0[2], t1[0], t1[2]}, sn[4] = {t0[1], t0[3], t1[1], t1[3]};
#pragma unroll
                                for (int e = 0; e < 4; ++e) { const float p = __shfl_xor(x[e], 32); const float r = (fq < 2) ? x[e] * cs[e] - p * sn[e] : x[e] * cs[e] + p * sn[e]; o[e] = lat ? r : x[e]; }
                            }
                            u32x2v w; w.x = pk2e(o[0] * sc, o[1] * sc); w.y = pk2e(o[2] * sc, o[3] * sc);
                            *(u32x2v*)(rowp + bj * HALF + 16 * n) = w;
                        }
                    }
                }
            }
    }
};
__device__ __forceinline__ float epi_shx(float v, int o, int lane) { return __int_as_float(__builtin_amdgcn_ds_bpermute((lane ^ o) << 2, __float_as_int(v))); }
struct EpiFuse {
    static constexpr bool PERM = true, AFTER_DRAIN = false;
    const float* hin; float* hout; bf16_t* U;
    const float* gY; const float* gate; const float* gU; const float* scale; const float* shift;
    float* X; unsigned* cnt; unsigned target0; PG8_LAS unsigned char* scr; float eps;
    __device__ __forceinline__ void xchg(const float (&ss)[2][4], float (&rs)[2][4], const Unit& u, int wr, int wc, int fr, int fq, int tid, int which) const {
        PG8_LAS float* P = (PG8_LAS float*)scr; PG8_LAS float* S = (PG8_LAS float*)(scr + 4096);
        if (fq == 0) {
#pragma unroll
            for (int ai = 0; ai < 2; ++ai)
#pragma unroll
                for (int m = 0; m < 4; ++m) P[(ai * 128 + wr * 64 + m * 16 + fr) * 4 + wc] = ss[ai][m]; }
        asm volatile("s_waitcnt lgkmcnt(0)" ::: "memory"); __builtin_amdgcn_s_barrier(); asm volatile("" ::: "memory");
        float* Xe = X + (size_t)which * (128 * 4 * 256) + (size_t)u.pm * 1024;
        unsigned* c = cnt + 64 * u.pm;
        if (tid < 256) { const f32x4 p = *(const PG8_LAS f32x4*)(P + tid * 4);
            __hip_atomic_store(Xe + u.pn * 256 + tid, (p[0] + p[1]) + (p[2] + p[3]), __ATOMIC_RELAXED, __HIP_MEMORY_SCOPE_AGENT); }
        asm volatile("s_waitcnt vmcnt(0)" ::: "memory");
        if (tid < 256 && (tid & 63) == 0) __hip_atomic_fetch_add(c, 1u, __ATOMIC_RELAXED, __HIP_MEMORY_SCOPE_AGENT);
        if (tid < 64) { const unsigned want = target0 + 16u * (unsigned)which; unsigned spins = 0;
            while ((unsigned)__builtin_amdgcn_readfirstlane(__hip_atomic_load(c, __ATOMIC_RELAXED, __HIP_MEMORY_SCOPE_AGENT)) < want) { __builtin_amdgcn_s_sleep(1); if (++spins > (1u << 20)) break; }
            __builtin_amdgcn_fence(__ATOMIC_ACQUIRE, "agent"); }
        asm volatile("s_waitcnt vmcnt(0) lgkmcnt(0)" ::: "memory"); __builtin_amdgcn_s_barrier(); asm volatile("" ::: "memory");
        if (tid < 256) { float t = 0.f;
#pragma unroll
            for (int q = 0; q < 4; ++q) t += __hip_atomic_load(Xe + q * 256 + tid, __ATOMIC_RELAXED, __HIP_MEMORY_SCOPE_AGENT);
            S[tid] = 1.0f / sqrtf(t * (1.f / 1024.f) + eps); }
        asm volatile("s_waitcnt vmcnt(0) lgkmcnt(0)" ::: "memory"); __builtin_amdgcn_s_barrier(); asm volatile("" ::: "memory");
#pragma unroll
        for (int ai = 0; ai < 2; ++ai)
#pragma unroll
            for (int m = 0; m < 4; ++m) rs[ai][m] = S[ai * 128 + wr * 64 + m * 16 + fr];
        asm volatile("s_waitcnt lgkmcnt(0)" ::: "memory");
    }
    __device__ __forceinline__ void operator()(f32x4 (&acc)[2][2][4][2], const Unit& u, int wr, int wc, int fr_, int fq_) const {
        int tid = threadIdx.x; asm volatile("" : "+v"(tid)); const int ln = tid & 63, fr = ln & 15, fq = ln >> 4; (void)fr_; (void)fq_;
        const int b = (u.pm * BM) >> 12; const int colb = u.pn * BM + wc * 32 + 8 * fq; const int row0 = u.pm * BM + wr * 64 + fr;
        float ss[2][4], rs[2][4];
#pragma unroll
        for (int ai = 0; ai < 2; ++ai)
#pragma unroll
            for (int m = 0; m < 4; ++m) { float s = 0.f;
#pragma unroll
                for (int bj = 0; bj < 2; ++bj)
#pragma unroll
                    for (int n = 0; n < 2; ++n) { const f32x4 v = acc[ai][bj][m][n]; s += (v[0] * v[0] + v[1] * v[1]) + (v[2] * v[2] + v[3] * v[3]); }
                s += epi_shx(s, 16, ln); s += epi_shx(s, 32, ln); ss[ai][m] = s; }
        f32x4 H[2][2][2];
#define EF_LOADH(ai_, mp_) do { _Pragma("unroll") for (int mm = 0; mm < 2; ++mm) { const size_t ro_ = (size_t)(row0 + (ai_) * HALF + (2 * (mp_) + mm) * 16) * 1024 + colb; \
            _Pragma("unroll") for (int bj = 0; bj < 2; ++bj) _Pragma("unroll") for (int n = 0; n < 2; ++n) H[mm][bj][n] = *(const f32x4*)(hin + ro_ + bj * HALF + 4 * n); } } while (0)
        EF_LOADH(0, 0);
        xchg(ss, rs, u, wr, wc, fr, fq, tid, 0);
        { f32x4 G[2][2];
#pragma unroll
          for (int bj = 0; bj < 2; ++bj)
#pragma unroll
              for (int n = 0; n < 2; ++n) G[bj][n] = *(const f32x4*)(gate + (size_t)b * 6144 + colb + bj * HALF + 4 * n) * *(const f32x4*)(gY + colb + bj * HALF + 4 * n);
#pragma unroll
          for (int ai = 0; ai < 2; ++ai)
#pragma unroll
              for (int mp = 0; mp < 2; ++mp) {
                  if (ai + mp > 0) EF_LOADH(ai, mp);
#pragma unroll
                  for (int mm = 0; mm < 2; ++mm) { const int m = 2 * mp + mm; const size_t ro = (size_t)(row0 + ai * HALF + m * 16) * 1024 + colb; float s = 0.f;
#pragma unroll
                      for (int bj = 0; bj < 2; ++bj)
#pragma unroll
                          for (int n = 0; n < 2; ++n) { const f32x4 v = H[mm][bj][n] + G[bj][n] * (acc[ai][bj][m][n] * rs[ai][m]);
                              *(f32x4*)(hout + ro + bj * HALF + 4 * n) = v; acc[ai][bj][m][n] = v; s += (v[0] * v[0] + v[1] * v[1]) + (v[2] * v[2] + v[3] * v[3]); }
                      s += epi_shx(s, 16, ln); s += epi_shx(s, 32, ln); ss[ai][m] = s; } } }
#undef EF_LOADH
        if (U) {
            xchg(ss, rs, u, wr, wc, fr, fq, tid, 1);
            f32x4 A2[2][2], B2[2][2];
#pragma unroll
            for (int bj = 0; bj < 2; ++bj)
#pragma unroll
                for (int n = 0; n < 2; ++n) { A2[bj][n] = *(const f32x4*)(gU + colb + bj * HALF + 4 * n) * (*(const f32x4*)(scale + (size_t)b * 6144 + colb + bj * HALF + 4 * n) + 1.f);
                    B2[bj][n] = *(const f32x4*)(shift + (size_t)b * 6144 + colb + bj * HALF + 4 * n); }
#pragma unroll
            for (int ai = 0; ai < 2; ++ai)
#pragma unroll
                for (int m = 0; m < 4; ++m) { bf16_t* up = U + (size_t)(row0 + ai * HALF + m * 16) * 1024 + colb;
#pragma unroll
                    for (int bj = 0; bj < 2; ++bj) { const f32x4 v0 = (acc[ai][bj][m][0] * rs[ai][m]) * A2[bj][0] + B2[bj][0], v1 = (acc[ai][bj][m][1] * rs[ai][m]) * A2[bj][1] + B2[bj][1];
                        u32x4 w; w.x = pk2e(v0[0], v0[1]); w.y = pk2e(v0[2], v0[3]); w.z = pk2e(v1[0], v1[1]); w.w = pk2e(v1[2], v1[3]); *(u32x4*)(up + bj * HALF) = w; } }
        }
    }
};
template <class Epi, class Sched, bool ALIGN_EPI = false, bool SP2 = false>
__device__ __forceinline__ void gemm_phase(PG8_LAS unsigned char* lds, const Gemm g, const Sched& S, const Epi& E) {
    int tid_l = threadIdx.x; asm volatile("" : "+v"(tid_l)); const int tid = tid_l, wid = __builtin_amdgcn_readfirstlane(tid >> 6), lane = tid & 63, wr = wid >> 2, wc = wid & 3, fr = lane & 15, fq = lane >> 4;
    const int K = g.K, nt = K / BK;
    unsigned voffA[2], voffB[2];
#pragma unroll
    for (int i = 0; i < 2; ++i) { int R, C; stage_rc(tid * 16 + i * 8192, R, C); const int Rb = Epi::PERM ? ((R & ~31) + perm32(R & 31)) : R;
        voffA[i] = (unsigned)(R * g.lda + C) * 2u; voffB[i] = (unsigned)(Rb * g.ldb + C) * 2u; }
    const size_t kstep = (size_t)(BK * 2);
    const size_t hstepA = (size_t)HALF * g.lda * 2, hstepB = (size_t)HALF * g.ldb * 2;
    const size_t tstepA = 2 * hstepA, tstepB = 2 * hstepB;
    const unsigned ldsw = (unsigned)wid * 1024u;
    const int aoff = lds_byte(wr * 64 + fr, fq * 8), boff = lds_byte(wc * 32 + fr, fq * 8);
#define PG8_SA(b, h) (((b) * 2 + (h)) * HTB)
#define PG8_SB(b, h) ((4 + (b) * 2 + (h)) * HTB)
#define PG8_STAGE(bufoff, gbase, voff) do { _Pragma("unroll") for (int _i = 0; _i < 2; ++_i) \
        __builtin_amdgcn_global_load_lds((const unsigned*)((const char*)(gbase) + (voff)[_i]), (PG8_LAS unsigned*)(lds + (bufoff) + ldsw + _i * 8192), 16, 0, 0); } while (0)
#define PG8_LDA(dst, b, h) do { _Pragma("unroll") for (int m = 0; m < 4; ++m) _Pragma("unroll") for (int k = 0; k < 2; ++k) dst[m][k] = *(const PG8_LAS bf16x8*)(lds + PG8_SA(b, h) + aoff + m * 2048 + k * 1024); } while (0)
#define PG8_LDB(dst, b, h) do { _Pragma("unroll") for (int n = 0; n < 2; ++n) _Pragma("unroll") for (int k = 0; k < 2; ++k) dst[n][k] = *(const PG8_LAS bf16x8*)(lds + PG8_SB(b, h) + boff + n * 2048 + k * 1024); } while (0)
#define PG8_MMA(ai, bj, At, Bt) do { __builtin_amdgcn_s_setprio(1); _Pragma("unroll") for (int m = 0; m < 4; ++m) _Pragma("unroll") for (int n = 0; n < 2; ++n) _Pragma("unroll") for (int k = 0; k < 2; ++k) \
        acc[ai][bj][m][n] = __builtin_amdgcn_mfma_f32_16x16x32_bf16(Bt[n][k], At[m][k], acc[ai][bj][m][n], 0, 0, 0); __builtin_amdgcn_s_setprio(0); } while (0)
#define PG8_WAIT_V(n) asm volatile("s_waitcnt vmcnt(" #n ")" ::: "memory")
#define PG8_WAIT_L(n) asm volatile("s_waitcnt lgkmcnt(" #n ")" ::: "memory")
#define PG8_BAR __builtin_amdgcn_s_barrier()
#define PG8_SCHED __builtin_amdgcn_sched_barrier(0)
    Unit cur, nxt; int ui = 0;
    if (!S.next(0, cur)) return;
    f32x4 acc[2][2][4][2];
#pragma unroll
    for (int a = 0; a < 2; ++a)
#pragma unroll
        for (int b = 0; b < 2; ++b)
#pragma unroll
            for (int m = 0; m < 4; ++m)
#pragma unroll
                for (int n = 0; n < 2; ++n) acc[a][b][m][n] = (f32x4){0.f, 0.f, 0.f, 0.f};
    bf16x8 At[4][2], B0[2][2], B1[2][2];
    const char* cA = (const char*)g.A + (size_t)cur.pm * tstepA; const char* cB = (const char*)g.Bt + (size_t)cur.pn * tstepB;
    S.a_ready(cur);
    if constexpr (SP2) {
        PG8_STAGE(PG8_SB(0, 0), cB, voffB); PG8_STAGE(PG8_SB(0, 1), cB + hstepB, voffB); PG8_STAGE(PG8_SA(0, 0), cA, voffA); PG8_STAGE(PG8_SA(0, 1), cA + hstepA, voffA);
        if (wr == 1) PG8_BAR;
        PG8_WAIT_V(2); PG8_BAR;
        PG8_STAGE(PG8_SB(1, 0), cB + kstep, voffB); PG8_STAGE(PG8_SA(1, 0), cA + kstep, voffA); PG8_STAGE(PG8_SB(1, 1), cB + hstepB + kstep, voffB);
        PG8_WAIT_V(6); PG8_BAR;
    } else {
        PG8_STAGE(PG8_SB(0, 0), cB, voffB); PG8_STAGE(PG8_SA(0, 0), cA, voffA); PG8_STAGE(PG8_SB(0, 1), cB + hstepB, voffB); PG8_STAGE(PG8_SA(0, 1), cA + hstepA, voffA);
        if (wr == 1) PG8_BAR;
        PG8_WAIT_V(4); PG8_BAR;
        PG8_STAGE(PG8_SB(1, 0), cB + kstep, voffB); PG8_STAGE(PG8_SA(1, 0), cA + kstep, voffA); PG8_STAGE(PG8_SB(1, 1), cB + hstepB + kstep, voffB);
        PG8_WAIT_V(6); PG8_BAR;
    }
    for (;;) {
        const bool has_next = S.next(ui + 1, nxt);
        const char* nA = has_next ? (const char*)g.A + (size_t)nxt.pm * tstepA : cA; const char* nB = has_next ? (const char*)g.Bt + (size_t)nxt.pn * tstepB : cB;
        for (int t = 0; t < nt; t += 2) {
            const bool last = (t == nt - 2);
            const char* a1 = cA + (size_t)(t + 1) * kstep;
            const char* a2 = last ? nA : cA + (size_t)(t + 2) * kstep; const char* b2 = last ? nB : cB + (size_t)(t + 2) * kstep;
            const char* a3 = a2 + kstep; const char* b3 = b2 + kstep;
            if (last && has_next) S.a_ready(nxt);
            if constexpr (SP2) {
            PG8_LDB(B0, 0, 0); PG8_LDB(B1, 0, 1); PG8_SCHED; PG8_LDA(At, 0, 0); PG8_STAGE(PG8_SA(1, 1), a1 + hstepA, voffA);
            PG8_WAIT_V(8); PG8_WAIT_L(0); PG8_BAR; PG8_MMA(0, 0, At, B0); PG8_MMA(0, 1, At, B1); PG8_BAR; PG8_SCHED;
            PG8_LDA(At, 0, 1); PG8_STAGE(PG8_SB(0, 0), b2, voffB); PG8_STAGE(PG8_SB(0, 1), b2 + hstepB, voffB); PG8_STAGE(PG8_SA(0, 0), a2, voffA);
            PG8_WAIT_V(8); PG8_WAIT_L(0); PG8_BAR; PG8_MMA(1, 0, At, B0); PG8_MMA(1, 1, At, B1); PG8_BAR; PG8_SCHED;
            PG8_LDB(B0, 1, 0); PG8_LDB(B1, 1, 1); PG8_SCHED; PG8_LDA(At, 1, 0); PG8_STAGE(PG8_SA(0, 1), a2 + hstepA, voffA);
            PG8_WAIT_V(8); PG8_WAIT_L(0); PG8_BAR; PG8_MMA(0, 0, At, B0); PG8_MMA(0, 1, At, B1); PG8_BAR; PG8_SCHED;
            PG8_LDA(At, 1, 1); PG8_STAGE(PG8_SB(1, 0), b3, voffB); PG8_STAGE(PG8_SB(1, 1), b3 + hstepB, voffB); PG8_STAGE(PG8_SA(1, 0), a3, voffA);
            PG8_WAIT_V(8); PG8_WAIT_L(0); PG8_BAR; PG8_MMA(1, 0, At, B0); PG8_MMA(1, 1, At, B1); PG8_BAR; PG8_SCHED;
            } else {
            PG8_LDB(B0, 0, 0); PG8_SCHED; PG8_LDA(At, 0, 0); PG8_STAGE(PG8_SA(1, 1), a1 + hstepA, voffA);
            PG8_WAIT_L(8); PG8_BAR; PG8_WAIT_L(0); PG8_MMA(0, 0, At, B0); PG8_BAR; PG8_SCHED;
            PG8_LDB(B1, 0, 1); PG8_STAGE(PG8_SB(0, 0), b2, voffB);
            PG8_BAR; PG8_WAIT_L(0); PG8_MMA(0, 1, At, B1); PG8_BAR;
            PG8_LDA(At, 0, 1); PG8_STAGE(PG8_SA(0, 0), a2, voffA);
            PG8_BAR; PG8_WAIT_L(0); PG8_MMA(1, 0, At, B0); PG8_BAR; PG8_SCHED;
            PG8_STAGE(PG8_SB(0, 1), b2 + hstepB, voffB);
            PG8_WAIT_V(6); PG8_BAR; PG8_MMA(1, 1, At, B1); PG8_BAR;
            PG8_LDB(B0, 1, 0); PG8_SCHED; PG8_LDA(At, 1, 0); PG8_STAGE(PG8_SA(0, 1), a2 + hstepA, voffA);
            PG8_WAIT_L(8); PG8_BAR; PG8_WAIT_L(0); PG8_MMA(0, 0, At, B0); PG8_BAR; PG8_SCHED;
            PG8_LDB(B1, 1, 1); PG8_STAGE(PG8_SB(1, 0), b3, voffB);
            PG8_BAR; PG8_WAIT_L(0); PG8_MMA(0, 1, At, B1); PG8_BAR;
            PG8_LDA(At, 1, 1); PG8_STAGE(PG8_SA(1, 0), a3, voffA);
            PG8_BAR; PG8_WAIT_L(0); PG8_MMA(1, 0, At, B0); PG8_BAR; PG8_SCHED;
            PG8_STAGE(PG8_SB(1, 1), b3 + hstepB, voffB);
            PG8_WAIT_V(6); PG8_BAR; PG8_MMA(1, 1, At, B1); PG8_BAR;
            }
        }
        if constexpr (ALIGN_EPI) { if (wr == 0) PG8_BAR; }
        if constexpr (!Epi::AFTER_DRAIN) { E(acc, cur, wr, wc, fr, fq); S.done(cur); }
        if (!has_next) break;
#pragma unroll
        for (int a = 0; a < 2; ++a)
#pragma unroll
            for (int b = 0; b < 2; ++b)
#pragma unroll
                for (int m = 0; m < 4; ++m)
#pragma unroll
                    for (int n = 0; n < 2; ++n) acc[a][b][m][n] = (f32x4){0.f, 0.f, 0.f, 0.f};
        cur = nxt; cA = nA; cB = nB; ++ui;
        if constexpr (ALIGN_EPI) { if (wr == 1) PG8_BAR; }
    }
    PG8_WAIT_V(0);
    if constexpr (!ALIGN_EPI) { if (wr == 0) PG8_BAR; }
    PG8_BAR;
    if constexpr (Epi::AFTER_DRAIN) { E.fused(acc, cur, wr, wc, fr, fq, lds, wid, lane); S.done(cur); }
#undef PG8_SA
#undef PG8_SB
#undef PG8_STAGE
#undef PG8_LDA
#undef PG8_LDB
#undef PG8_MMA
#undef PG8_WAIT_V
#undef PG8_WAIT_L
#undef PG8_BAR
#undef PG8_SCHED
}
}
#define LAS __attribute__((address_space(3)))
typedef unsigned short bf16;
typedef short bf16x8 __attribute__((ext_vector_type(8)));
typedef float f32x4 __attribute__((ext_vector_type(4)));
typedef float f32x16 __attribute__((ext_vector_type(16)));
typedef unsigned u32x4 __attribute__((ext_vector_type(4)));
typedef unsigned u32x2 __attribute__((ext_vector_type(2)));
typedef float f32x2_t __attribute__((ext_vector_type(2)));
typedef __bf16 bf16x2_t __attribute__((ext_vector_type(2)));

constexpr int D = 1024, NB = 8, SEQ = 4096, CTXL = 256, FF = 4096;
constexpr int TL = NB * SEQ, TC = NB * CTXL, MT = TL + TC;
constexpr float EPS = 1e-6f, LOG2E = 1.4426950408889634f;
constexpr int NTHREADS = 512, NWAVES = 8;
constexpr size_t MiB = 1u << 20;
constexpr size_t WS_TAB = 0;
constexpr size_t WS_XBAR = 32768;
constexpr size_t WS_XCNT = 49152;
constexpr size_t WS_XBUF = 38 * MiB;
constexpr size_t WS_MODS = 1 * MiB;
constexpr size_t WS_HC = 2 * MiB;
constexpr size_t WS_KR = 10 * MiB;
constexpr size_t WS_W = 14 * MiB;
constexpr size_t WS_WSTRIDE = 26 * MiB;
constexpr size_t WS_U = 66 * MiB;
constexpr size_t WS_Y = 134 * MiB;
constexpr size_t WS_BIG = 202 * MiB;
constexpr size_t WS_YP = 474 * MiB;
constexpr size_t WS_END = 506 * MiB;
constexpr size_t WO_W1 = 0, WO_W2 = 4u << 20, WO_WO = 8u << 20, WO_MIX = 9u << 20;
constexpr int LDS_BYTES = 147456;
constexpr int MODS_PER_LAYER = 9 * 6144;

__device__ __forceinline__ unsigned pk2(float lo, float hi) { f32x2_t v = {lo, hi}; bf16x2_t b = __builtin_convertvector(v, bf16x2_t); return __builtin_bit_cast(unsigned, b); }
__device__ __forceinline__ float bflo(unsigned u) { return __uint_as_float(u << 16); }
__device__ __forceinline__ float bfhi(unsigned u) { return __uint_as_float(u & 0xffff0000u); }
__device__ __forceinline__ float shx(float v, int o, int lane) { return __int_as_float(__builtin_amdgcn_ds_bpermute((lane ^ o) << 2, __float_as_int(v))); }
__device__ __forceinline__ float wave_sum(float v, int lane) {
#pragma unroll
    for (int o = 1; o < 64; o <<= 1) v += shx(v, o, lane);
    return v;
}
__device__ __forceinline__ float xor32(float v, int hh) {
    const unsigned u = __float_as_uint(v);
    auto r = __builtin_amdgcn_permlane32_swap(u, u, false, false);
    return __uint_as_float(hh ? r[0] : r[1]);
}

struct LayerPtrs { const float *ada_w, *ada_b, *norms, *w_a, *w_o, *w1, *w2, *x0, *x1, *w_uq, *w_ukv; };
struct Params { const float *x, *c, *ctx, *c_ctx; float* out; unsigned char* ws; LayerPtrs L[4]; };
#define XB_TMO      128
#define XB_XCNT(j)  (256  + 64 * (j))
#define XB_XSUB(j)  (1280 + 64 * (j))
#define XB_XGEN(j)  (2304 + 64 * (j))
#define XB_TOP      3328
#define XB_TOPGEN   3392
#define XCD_BAR_WORDS 3456
#define XB_SPIN_CAP (1u << 18)

__device__ __forceinline__ unsigned xb_ld(unsigned* p)              { return __hip_atomic_load(p, __ATOMIC_RELAXED, __HIP_MEMORY_SCOPE_AGENT); }
__device__ __forceinline__ unsigned xb_add(unsigned* p, unsigned v) { return __hip_atomic_fetch_add(p, v, __ATOMIC_RELAXED, __HIP_MEMORY_SCOPE_AGENT); }
__device__ __forceinline__ unsigned xb_xcc_id() { return (unsigned)__builtin_amdgcn_s_getreg((3 << 11) | 20) & 0xFu; }
#define XB_SPIN(cond, bar) do { unsigned _sp = 0; while (cond) { __builtin_amdgcn_s_sleep(1); \
    if ((++_sp & 255u) == 0u) { if (xb_ld(&(bar)[XB_TMO])) break; if (_sp > XB_SPIN_CAP) { atomicAdd(&(bar)[XB_TMO], 1u); break; } } } } while (0)

struct XcdBarrier {
    unsigned* bar; unsigned x;
    volatile LAS unsigned* st;
};

__device__ __forceinline__ XcdBarrier xcd_barrier_post(unsigned* bar, volatile LAS unsigned* st) {
    XcdBarrier b; b.bar = bar; b.x = xb_xcc_id(); b.st = st;
    if (threadIdx.x == 0) (void)xb_add(&bar[XB_XCNT(b.x)], 1u);
    return b;
}
__device__ __forceinline__ void xcd_barrier_complete(unsigned* bar, unsigned x, unsigned& nloc, unsigned& nx) {
    const unsigned G = gridDim.x * gridDim.y * gridDim.z;
    unsigned sum, cnt, mine, sp = 0u;
    for (;;) {
        sum = 0u; cnt = 0u; mine = 0u;
#pragma unroll
        for (unsigned j = 0; j < 16; ++j) { const unsigned c = xb_ld(&bar[XB_XCNT(j)]); sum += c; cnt += (c > 0u) ? 1u : 0u; mine = (j == x) ? c : mine; }
        if (sum == G) break;
        __builtin_amdgcn_s_sleep(1);
        if ((++sp & 255u) == 0u) { if (xb_ld(&bar[XB_TMO])) break; if (sp > XB_SPIN_CAP) { atomicAdd(&bar[XB_TMO], 1u); break; } }
    }
    nloc = mine > 0u ? mine : 1u; nx = cnt > 0u ? cnt : 1u;
}

__device__ __forceinline__ void xcd_barrier(const XcdBarrier& b) {
    asm volatile("s_waitcnt vmcnt(0)" ::: "memory");
    __syncthreads();
    if (threadIdx.x == 0) {
        unsigned* bar = b.bar;
        __builtin_amdgcn_s_waitcnt(0);
        unsigned nloc = b.st[0], nx = b.st[1];
        if (nloc == 0u) { xcd_barrier_complete(bar, b.x, nloc, nx); b.st[0] = nloc; b.st[1] = nx; }
        const unsigned old = xb_add(&bar[XB_XSUB(b.x)], 1u);
        const unsigned gen = old / nloc;
        if (old + 1u == (gen + 1u) * nloc) {
            __builtin_amdgcn_fence(__ATOMIC_RELEASE, "agent");
            asm volatile("s_waitcnt vmcnt(0)" ::: "memory");
            const unsigned og = xb_add(&bar[XB_TOP], 1u);
            const unsigned tg = og / nx;
            if (og + 1u == (tg + 1u) * nx) xb_add(&bar[XB_TOPGEN], 1u);
            else XB_SPIN(xb_ld(&bar[XB_TOPGEN]) == tg, bar);
            __builtin_amdgcn_fence(__ATOMIC_ACQUIRE, "agent");
            xb_add(&bar[XB_XGEN(b.x)], 1u);
            asm volatile("s_waitcnt vmcnt(0)" ::: "memory");
        } else {
            XB_SPIN(xb_ld(&bar[XB_XGEN(b.x)]) == gen, bar);
            __builtin_amdgcn_fence(__ATOMIC_ACQUIRE, "agent");
            asm volatile("s_waitcnt vmcnt(0)" ::: "memory");
        }
    }
    __syncthreads();
}
constexpr float AT_THR = 24.f;
#define AT_BAR() do { asm volatile("s_waitcnt lgkmcnt(0)" ::: "memory"); __builtin_amdgcn_s_barrier(); asm volatile("" ::: "memory"); } while (0)
constexpr int AT_KB = 12288, AT_VB = 16384, AT_K0 = 0, AT_V0 = 3 * AT_KB;
template <int DQ, int DV, bool WINDOW, bool GQA = false>
__device__ __forceinline__ void attn_phase(LAS unsigned char* lds, const bf16* __restrict__ Q, int ldq, const bf16* __restrict__ K1, int ldk, int kshift,
                                           const bf16* __restrict__ KR, const bf16* __restrict__ Vt, int vshift, bf16* __restrict__ O, int ldo,
                                           const float* __restrict__ sink, int nunits_lat, int nunits_ctx) {
    constexpr int NKS = DQ / 16, NV = DV / 32, KROWB = DQ * 2, NVL = DV / 64, NKL = (DQ == 64) ? 1 : 2;
    int tid_l = threadIdx.x; asm volatile("" : "+v"(tid_l)); const int tid = tid_l, lane = tid & 63, wave = __builtin_amdgcn_readfirstlane(tid >> 6), r32 = lane & 31, hh = lane >> 5;
    int grp;
    { LAS unsigned* cnt = (LAS unsigned*)(lds + 138240);
      if (tid < 4) cnt[tid] = 0u;
      AT_BAR();
      const unsigned simd = (unsigned)__builtin_amdgcn_s_getreg((1 << 11) | (4 << 6) | 4) & 3u;
      unsigned old = 0u; if (lane == 0) old = __hip_atomic_fetch_add(cnt + simd, 1u, __ATOMIC_RELAXED, __HIP_MEMORY_SCOPE_WORKGROUP);
      grp = (int)(__builtin_amdgcn_readfirstlane(old) & 1u);
      AT_BAR(); }
    const int pk = (r32 & ~0xC) | ((r32 & 4) << 1) | ((r32 & 8) >> 1);
    int koff[NKS];
#pragma unroll
    for (int ks = 0; ks < NKS; ++ks) { const int c = 2 * ks + hh; const int sw = (DQ == 64) ? ((pk >> 1) & 7) : ((pk >> 2) & 3); koff[ks] = pk * KROWB + ((c ^ sw) << 4); }
    int voff[4];
#pragma unroll
    for (int ts = 0; ts < 4; ++ts) voff[ts] = r32 * 128 + (((2 * ts + hh) ^ ((r32 >> 1) & 7)) << 4);
    const int nunits = nunits_lat + nunits_ctx;
    int bid_ = blockIdx.x; asm volatile("" : "+s"(bid_));
    const int gsz_ = gridDim.x; const int vcu_ = (gsz_ % 8 == 0) ? (bid_ % 8) * (gsz_ / 8) + bid_ / 8 : bid_;
    for (int u = vcu_; u < nunits; u += gsz_) {
        const bool isctx = u >= nunits_lat; int b, hq, qrow0;
        if (!GQA) { int qb; if (!isctx) { qb = u & 15; hq = (u >> 4) & 15; b = u >> 8; } else { const int v = u - nunits_lat; hq = v & 15; b = v >> 4; qb = 0; } qrow0 = qb * 256 + wave * 32; }
        else { int qb64, kvh; if (!isctx) { qb64 = u & 63; kvh = (u >> 6) & 3; b = u >> 8; } else { const int v = u - nunits_lat; qb64 = v & 3; kvh = (v >> 2) & 3; b = v >> 4; } hq = kvh * 4 + (wave >> 1); qrow0 = qb64 * 64 + (wave & 1) * 32; }
        const int ublk0 = GQA ? (qrow0 & ~63) : (qrow0 & ~255), ublen = GQA ? 64 : 256;
        const int mqw = (isctx ? TL + b * CTXL : b * SEQ) + qrow0;
        int lt0 = 0, nlt = 0;
        if (!isctx) { if (WINDOW) { const int lo = (ublk0 - 128) < 0 ? 0 : (ublk0 - 128); const int hi = (ublk0 + ublen + 128) > SEQ ? SEQ : (ublk0 + ublen + 128); lt0 = lo >> 6; nlt = (hi - lo) >> 6; } else { lt0 = 0; nlt = 64; } }
        const int nt = 4 + nlt;
        bf16x8 qf[NKS];
        { const bf16* qp = Q + (size_t)(mqw + r32) * ldq + hq * DQ + 8 * hh;
#pragma unroll
          for (int ks = 0; ks < NKS; ++ks) qf[ks] = *(const bf16x8*)(qp + 16 * ks); }
        float m_run, l_run;
        m_run = 0.f; l_run = (sink && hh == 0) ? __builtin_amdgcn_exp2f(sink[hq] * LOG2E) : 0.f;
        f32x16 o[NV];
#pragma unroll
        for (int v = 0; v < NV; ++v)
#pragma unroll
            for (int i = 0; i < 16; ++i) o[v][i] = 0.f;
        const bf16* kbase = K1 + (size_t)(hq >> kshift) * 64;
        const bf16* vbase = Vt + (size_t)((hq >> vshift) * DV) * MT;
        bf16x8 pf[2]; f32x16 s1k; bool pact = true;
#pragma unroll
        for (int i = 0; i < 16; ++i) s1k[i] = 0.f;
#define AT_M0(t) ((t) < 4 ? (TL + b * CTXL + 64 * (t)) : (b * SEQ + (lt0 + (t) - 4) * 64))
#define AT_DMA(src_, dst_) __builtin_amdgcn_global_load_lds((const unsigned*)(src_), (LAS unsigned*)(dst_), 16, 0, 0)
#define AT_LOADK(t, sl) do { const int m0_ = AT_M0(t); LAS unsigned char* kd_ = lds + AT_K0 + (sl) * AT_KB; \
        if (DQ == 64) { const int row = 8 * wave + (lane >> 3), c = (lane & 7) ^ ((row >> 1) & 7); AT_DMA(kbase + (size_t)(m0_ + row) * ldk + 8 * c, kd_ + 1024 * wave); } \
        else { _Pragma("unroll") for (int i = 0; i < 2; ++i) { const int piece = (i == 0) ? wave : (wave < 4 ? wave + 8 : wave); const int o_ = 1024 * piece + 16 * lane; \
                 const int row = o_ / 192, c = ((o_ % 192) >> 4) ^ ((row >> 2) & 3); \
                 const bf16* src = (c < 8) ? kbase + (size_t)(m0_ + row) * ldk + 8 * c : KR + (size_t)(m0_ + row) * 32 + 8 * (c - 8); AT_DMA(src, kd_ + 1024 * piece); } } } while (0)
#define AT_LOADV(t, sl) do { const int m0_ = AT_M0(t); LAS unsigned char* vd_ = lds + AT_V0 + (sl) * AT_VB; \
        _Pragma("unroll") for (int i = 0; i < NVL; ++i) { const int piece = wave + 8 * i; const int row = 8 * piece + (lane >> 3), c16 = (lane & 7) ^ ((row >> 1) & 7); \
            AT_DMA(vbase + (size_t)row * MT + m0_ + 8 * c16, vd_ + 1024 * piece); } } while (0)
#define AT_VMW(n) asm volatile("s_waitcnt vmcnt(%0)" :: "n"(n) : "memory")
#define AT_QKS(te, sl) do { \
        bool active = true; int kpos0 = 0; const bool lat_tile = (te) >= 4; \
        if (lat_tile) kpos0 = (lt0 + (te) - 4) * 64; \
        if (WINDOW && lat_tile) { const int qa = qrow0; active = (kpos0 + 63 >= qa - 128) && (kpos0 <= qa + 31 + 128); } \
        pact = active; \
        if (active) { \
            const LAS unsigned char* kb = lds + AT_K0 + (sl) * AT_KB; \
            f32x16 s0, s1; bf16x8 ka[NKS][2]; \
            _Pragma("unroll") for (int ks = 0; ks < NKS; ++ks) { ka[ks][0] = *(const LAS bf16x8*)(kb + koff[ks]); ka[ks][1] = *(const LAS bf16x8*)(kb + koff[ks] + 32 * KROWB); } \
            __builtin_amdgcn_sched_barrier(0); \
            { f32x16 z_; _Pragma("unroll") for (int i = 0; i < 16; ++i) z_[i] = 0.f; \
              s0 = __builtin_amdgcn_mfma_f32_32x32x16_bf16(ka[0][0], qf[0], z_, 0, 0, 0); s1 = __builtin_amdgcn_mfma_f32_32x32x16_bf16(ka[0][1], qf[0], z_, 0, 0, 0); } \
            _Pragma("unroll") for (int ks = 1; ks < NKS; ++ks) { s0 = __builtin_amdgcn_mfma_f32_32x32x16_bf16(ka[ks][0], qf[ks], s0, 0, 0, 0); s1 = __builtin_amdgcn_mfma_f32_32x32x16_bf16(ka[ks][1], qf[ks], s1, 0, 0, 0); } \
            __builtin_amdgcn_sched_barrier(0); \
            if (__any(m_run != 0.f)) { _Pragma("unroll") for (int i = 0; i < 16; ++i) { s0[i] -= m_run; s1[i] -= m_run; } }     \
            if (WINDOW && lat_tile) { \
                const int qp = qrow0 + r32; float negbig = -1e30f; asm volatile("" : "+v"(negbig)); \
                _Pragma("unroll") for (int i = 0; i < 16; ++i) { const int kr = kpos0 + (i & 3) + 4 * ((i >> 2) & 1) + 8 * hh + 16 * (i >> 3); const int d0 = qp - kr, d1 = qp - (kr + 32); \
                    if (d0 > 128 || d0 < -128) s0[i] = negbig; if (d1 > 128 || d1 < -128) s1[i] = negbig; } \
            } \
            float mx = s0[0]; \
            _Pragma("unroll") for (int i = 1; i < 16; ++i) mx = fmaxf(mx, s0[i]); \
            _Pragma("unroll") for (int i = 0; i < 16; ++i) mx = fmaxf(mx, s1[i]); \
            mx = fmaxf(mx, xor32(mx, hh)); \
            if (__any(mx > AT_THR)) { \
                const float delta = fmaxf(mx, 0.f); const float alpha = __builtin_amdgcn_exp2f(-delta); \
                m_run += delta; l_run *= alpha; \
                _Pragma("unroll") for (int i = 0; i < 16; ++i) { s0[i] -= delta; s1[i] -= delta; } \
                _Pragma("unroll") for (int v = 0; v < NV; ++v) _Pragma("unroll") for (int i = 0; i < 16; ++i) o[v][i] *= alpha; \
            } \
            float ps = 0.f; \
            _Pragma("unroll") for (int i = 0; i < 16; ++i) { s0[i] = __builtin_amdgcn_exp2f(s0[i]); ps += s0[i]; } \
            l_run += ps; \
            { u32x4 w; w.x = pk2(s0[0], s0[1]); w.y = pk2(s0[2], s0[3]); w.z = pk2(s0[4], s0[5]); w.w = pk2(s0[6], s0[7]); pf[0] = __builtin_bit_cast(bf16x8, w); \
              w.x = pk2(s0[8], s0[9]); w.y = pk2(s0[10], s0[11]); w.z = pk2(s0[12], s0[13]); w.w = pk2(s0[14], s0[15]); pf[1] = __builtin_bit_cast(bf16x8, w); } \
            s1k = s1; \
        } } while (0)
#define AT_PV(te, sl) do { if (pact) { \
            const LAS unsigned char* vb = lds + AT_V0 + (sl) * AT_VB; \
            bf16x8 vfa[NV][2]; \
            _Pragma("unroll") for (int v = 0; v < NV; ++v) { vfa[v][0] = *(const LAS bf16x8*)(vb + 32 * 128 * v + voff[0]); vfa[v][1] = *(const LAS bf16x8*)(vb + 32 * 128 * v + voff[1]); } \
            __builtin_amdgcn_sched_barrier(0); \
            __builtin_amdgcn_s_setprio(1); \
            _Pragma("unroll") for (int v = 0; v < NV; ++v) { o[v] = __builtin_amdgcn_mfma_f32_32x32x16_bf16(vfa[v][0], pf[0], o[v], 0, 0, 0); o[v] = __builtin_amdgcn_mfma_f32_32x32x16_bf16(vfa[v][1], pf[1], o[v], 0, 0, 0); } \
            __builtin_amdgcn_s_setprio(0); \
            __builtin_amdgcn_sched_barrier(0); \
            _Pragma("unroll") for (int v = 0; v < NV; ++v) { vfa[v][0] = *(const LAS bf16x8*)(vb + 32 * 128 * v + voff[2]); vfa[v][1] = *(const LAS bf16x8*)(vb + 32 * 128 * v + voff[3]); } \
            bf16x8 pf2, pf3; \
            { float ps = 0.f; \
              _Pragma("unroll") for (int i = 0; i < 16; ++i) { s1k[i] = __builtin_amdgcn_exp2f(s1k[i]); ps += s1k[i]; } \
              l_run += ps; \
              u32x4 w; w.x = pk2(s1k[0], s1k[1]); w.y = pk2(s1k[2], s1k[3]); w.z = pk2(s1k[4], s1k[5]); w.w = pk2(s1k[6], s1k[7]); pf2 = __builtin_bit_cast(bf16x8, w); \
              w.x = pk2(s1k[8], s1k[9]); w.y = pk2(s1k[10], s1k[11]); w.z = pk2(s1k[12], s1k[13]); w.w = pk2(s1k[14], s1k[15]); pf3 = __builtin_bit_cast(bf16x8, w); } \
            __builtin_amdgcn_sched_barrier(0); \
            __builtin_amdgcn_s_setprio(1); \
            _Pragma("unroll") for (int v = 0; v < NV; ++v) { o[v] = __builtin_amdgcn_mfma_f32_32x32x16_bf16(vfa[v][0], pf2, o[v], 0, 0, 0); o[v] = __builtin_amdgcn_mfma_f32_32x32x16_bf16(vfa[v][1], pf3, o[v], 0, 0, 0); } \
            __builtin_amdgcn_s_setprio(0); \
            __builtin_amdgcn_sched_barrier(0); \
        } } while (0)
        int k0_ = 0, k1_ = 1, k2_ = 2;
        AT_LOADK(0, 0); AT_LOADV(0, 0); AT_LOADK(1, 1); AT_LOADV(1, 1); AT_VMW(NKL + NVL); AT_BAR();
        if (grp == 0) {
            for (int t = 0; t < nt; ++t) {
                const bool deep = t + 2 < nt;
                if (deep) { AT_LOADK(t + 2, k2_); AT_LOADV(t + 2, (t + 2) & 3); }
                AT_QKS(t, k0_);
                AT_PV(t, t & 3);
                if (deep) AT_VMW(NKL + NVL); else AT_VMW(0);
                AT_BAR();
                { const int r_ = k0_; k0_ = k1_; k1_ = k2_; k2_ = r_; }
            }
            AT_BAR();
        } else {
            { const bool deep = 2 < nt; if (deep) { AT_LOADK(2, k2_); AT_LOADV(2, 2); }
              AT_QKS(0, k0_);
              if (deep) AT_VMW(NKL + NVL); else AT_VMW(0);
              AT_BAR();
              { const int r_ = k0_; k0_ = k1_; k1_ = k2_; k2_ = r_; } }
            for (int t = 1; t < nt; ++t) {
                const bool deep = t + 2 < nt;
                if (deep) { AT_LOADK(t + 2, k2_); AT_LOADV(t + 2, (t + 2) & 3); }
                AT_PV(t - 1, (t - 1) & 3);
                AT_QKS(t, k0_);
                if (deep) AT_VMW(NKL + NVL); else AT_VMW(0);
                AT_BAR();
                { const int r_ = k0_; k0_ = k1_; k1_ = k2_; k2_ = r_; }
            }
            AT_PV(nt - 1, (nt - 1) & 3);
            AT_BAR();
        }
        const float lt = l_run + xor32(l_run, hh); const float inv = 1.f / lt;
        bf16* op = O + (size_t)(mqw + r32) * ldo + hq * DV + 8 * hh;
#pragma unroll
        for (int v = 0; v < NV; ++v)
#pragma unroll
            for (int g = 0; g < 4; g += 2) {
                unsigned ax = pk2(o[v][4 * g] * inv, o[v][4 * g + 1] * inv), ay = pk2(o[v][4 * g + 2] * inv, o[v][4 * g + 3] * inv);
                unsigned bx = pk2(o[v][4 * g + 4] * inv, o[v][4 * g + 5] * inv), by = pk2(o[v][4 * g + 6] * inv, o[v][4 * g + 7] * inv);
                auto r0 = __builtin_amdgcn_permlane32_swap(ax, bx, false, false); auto r1 = __builtin_amdgcn_permlane32_swap(ay, by, false, false);
                u32x4 w; w.x = r0[0]; w.y = r1[0]; w.z = r0[1]; w.w = r1[1];
                *(u32x4*)(op + 32 * v + 8 * g) = w; }
#undef AT_M0
#undef AT_LOADK
#undef AT_LOADV
#undef AT_DMA
#undef AT_VMW
#undef AT_QKS
#undef AT_PV
    }
}
__device__ __forceinline__ void post_pass(int gw, int ngw, int lane, const bf16* __restrict__ Y, const float* __restrict__ gY, const float* __restrict__ modsY, int gate_idx,
                                          const float* hin_lat, const float* hin_ctx, float* hout_lat, float* hout_ctx,
                                          bf16* __restrict__ U, const float* __restrict__ gU, const float* __restrict__ modsU, int shift_idx, int scale_idx, int nrows,
                                          const bf16* __restrict__ Yp = nullptr, int nparts = 0, int row_begin = 0) {
    float eps_ = EPS; asm volatile("" : "+v"(eps_));
    for (int r = row_begin + gw; r < nrows; r += ngw) {
        const bool lat = r < TL; const int mb = lat ? (r >> 12) : 8;
        const float* hi_ = lat ? hin_lat + (size_t)r * D : hin_ctx + (size_t)(r - TL) * D;
        f32x4 h[4];
#pragma unroll
        for (int j = 0; j < 4; ++j) h[j] = *(const f32x4*)(hi_ + 256 * j + 4 * lane);
        if (Y) {
            f32x4 y[4]; float ss = 0.f;
            if (Yp && !lat) {
#pragma unroll
                for (int j = 0; j < 4; ++j) y[j] = (f32x4){0.f, 0.f, 0.f, 0.f};
                for (int k = 0; k < nparts; ++k) { const bf16* yr = Yp + ((size_t)k * TC + (r - TL)) * D;
#pragma unroll
                    for (int j = 0; j < 4; ++j) { const u32x2 w = *(const u32x2*)(yr + 256 * j + 4 * lane); y[j] = y[j] + (f32x4){bflo(w.x), bfhi(w.x), bflo(w.y), bfhi(w.y)}; } }
            } else { const bf16* yr = Y + (size_t)r * D;
#pragma unroll
                for (int j = 0; j < 4; ++j) { const u32x2 w = *(const u32x2*)(yr + 256 * j + 4 * lane); y[j] = (f32x4){bflo(w.x), bfhi(w.x), bflo(w.y), bfhi(w.y)}; } }
#pragma unroll
            for (int j = 0; j < 4; ++j) ss += (y[j][0] * y[j][0] + y[j][1] * y[j][1]) + (y[j][2] * y[j][2] + y[j][3] * y[j][3]);
            const float rs = rsqrtf(wave_sum(ss, lane) * (1.f / D) + eps_);
            const float* gt = modsY + (size_t)mb * 6144 + gate_idx * D;
            float* ho = lat ? hout_lat + (size_t)r * D : hout_ctx + (size_t)(r - TL) * D;
#pragma unroll
            for (int j = 0; j < 4; ++j) { const f32x4 g = *(const f32x4*)(gY + 256 * j + 4 * lane); const f32x4 ga = *(const f32x4*)(gt + 256 * j + 4 * lane);
                h[j] = h[j] + ga * (y[j] * rs * g); *(f32x4*)(ho + 256 * j + 4 * lane) = h[j]; }
        }
        if (U) {
            float ss = 0.f;
#pragma unroll
            for (int j = 0; j < 4; ++j) ss += (h[j][0] * h[j][0] + h[j][1] * h[j][1]) + (h[j][2] * h[j][2] + h[j][3] * h[j][3]);
            const float rs = rsqrtf(wave_sum(ss, lane) * (1.f / D) + eps_);
            const float* sh = modsU + (size_t)mb * 6144 + shift_idx * D; const float* sc = modsU + (size_t)mb * 6144 + scale_idx * D;
            bf16* ur = U + (size_t)r * D;
#pragma unroll
            for (int j = 0; j < 4; ++j) { const f32x4 g = *(const f32x4*)(gU + 256 * j + 4 * lane); const f32x4 s1 = *(const f32x4*)(sc + 256 * j + 4 * lane); const f32x4 s0 = *(const f32x4*)(sh + 256 * j + 4 * lane);
                const f32x4 v = (h[j] * rs * g) * (s1 + 1.f) + s0; u32x2 w; w.x = pk2(v[0], v[1]); w.y = pk2(v[2], v[3]); *(u32x2*)(ur + 256 * j + 4 * lane) = w; }
        }
    }
}
__device__ __forceinline__ void diff_combine(int gw, int ngw, int lane, const bf16* __restrict__ OB, bf16* __restrict__ ATT, const float* __restrict__ lam, const float* __restrict__ subln, float lam_init) {
    const float p1 = wave_sum(lam[lane] * lam[64 + lane], lane), p2 = wave_sum(lam[128 + lane] * lam[192 + lane], lane);
    const float lam_full = expf(p1) - expf(p2) + lam_init;
    const int hd = lane >> 3, j0 = (lane & 7) * 16;
    float g[16];
#pragma unroll
    for (int e = 0; e < 16; ++e) g[e] = subln[j0 + e] * (1.f - lam_init);
    for (int r = gw; r < MT; r += ngw) {
        const bf16* p = OB + (size_t)r * 2048 + hd * 256 + j0;
        const u32x4 a0 = *(const u32x4*)p, a1 = *(const u32x4*)(p + 8), b0 = *(const u32x4*)(p + 128), b1 = *(const u32x4*)(p + 136);
        const unsigned aw[8] = {a0.x, a0.y, a0.z, a0.w, a1.x, a1.y, a1.z, a1.w}, bw[8] = {b0.x, b0.y, b0.z, b0.w, b1.x, b1.y, b1.z, b1.w};
        float o[16]; float ss = 0.f;
#pragma unroll
        for (int e = 0; e < 8; ++e) { o[2 * e] = bflo(aw[e]) - lam_full * bflo(bw[e]); o[2 * e + 1] = bfhi(aw[e]) - lam_full * bfhi(bw[e]); ss += o[2 * e] * o[2 * e] + o[2 * e + 1] * o[2 * e + 1]; }
        ss += shx(ss, 1, lane); ss += shx(ss, 2, lane); ss += shx(ss, 4, lane);
        const float rs = rsqrtf(ss * (1.f / 128.f) + EPS);
        u32x4 w0, w1;
        w0.x = pk2(o[0] * rs * g[0], o[1] * rs * g[1]); w0.y = pk2(o[2] * rs * g[2], o[3] * rs * g[3]); w0.z = pk2(o[4] * rs * g[4], o[5] * rs * g[5]); w0.w = pk2(o[6] * rs * g[6], o[7] * rs * g[7]);
        w1.x = pk2(o[8] * rs * g[8], o[9] * rs * g[9]); w1.y = pk2(o[10] * rs * g[10], o[11] * rs * g[11]); w1.z = pk2(o[12] * rs * g[12], o[13] * rs * g[13]); w1.w = pk2(o[14] * rs * g[14], o[15] * rs * g[15]);
        bf16* q = ATT + (size_t)r * D + hd * 128 + j0; *(u32x4*)q = w0; *(u32x4*)(q + 8) = w1;
    }
}
__device__ __forceinline__ void mla_norm(int gw, int ngw, int lane, bf16* __restrict__ CQ, bf16* __restrict__ KR, const float* __restrict__ qn, const float* __restrict__ kvn, const float* __restrict__ tab32) {
    for (int r = gw; r < MT; r += ngw) {
        bf16* row = CQ + (size_t)r * 768;
        unsigned* cq = (unsigned*)(row + 6 * lane); unsigned a0 = cq[0], a1 = cq[1], a2 = cq[2];
        float x[6] = {bflo(a0), bfhi(a0), bflo(a1), bfhi(a1), bflo(a2), bfhi(a2)}; float ss = 0.f;
#pragma unroll
        for (int e = 0; e < 6; ++e) ss += x[e] * x[e];
        float rs = rsqrtf(wave_sum(ss, lane) * (1.f / 384.f) + EPS);
#pragma unroll
        for (int e = 0; e < 6; ++e) x[e] = x[e] * rs * qn[6 * lane + e];
        cq[0] = pk2(x[0], x[1]); cq[1] = pk2(x[2], x[3]); cq[2] = pk2(x[4], x[5]);
        u32x2* ck = (u32x2*)(row + 384 + 4 * lane); u32x2 b = *ck; float y[4] = {bflo(b.x), bfhi(b.x), bflo(b.y), bfhi(b.y)};
        ss = y[0] * y[0] + y[1] * y[1] + y[2] * y[2] + y[3] * y[3];
        rs = rsqrtf(wave_sum(ss, lane) * (1.f / 256.f) + EPS);
#pragma unroll
        for (int e = 0; e < 4; ++e) y[e] = y[e] * rs * kvn[4 * lane + e];
        b.x = pk2(y[0], y[1]); b.y = pk2(y[2], y[3]); *ck = b;
        const int l = lane & 31; const float v = __uint_as_float((unsigned)row[640 + l] << 16);
        const float p = shx(v, 8, lane);
        float outv = v;
        if (r < TL) { const int s = r & 4095; const int pos = (l & 16) ? (s & 63) : (s >> 6); const float cs = tab32[(pos * 8 + (l & 7)) * 2], sn = tab32[(pos * 8 + (l & 7)) * 2 + 1];
            outv = (l & 8) ? v * cs + p * sn : v * cs - p * sn; }
        const float nb = shx(outv, 1, lane);
        if (lane < 32 && !(lane & 1)) *(unsigned*)(KR + (size_t)r * 32 + lane) = pk2(outv, nb);
    }
}
__device__ __forceinline__ void conv_tile(LAS float* scr, const float* __restrict__ src, int N, int k0, int c0, bf16* __restrict__ dst, int ldd, int drow0, int tid) {
    const int nn = tid & 63, kq = tid >> 6;
#pragma unroll
    for (int i = 0; i < 8; ++i) { const int kk = kq + 8 * i; scr[kk * 65 + nn] = (c0 + nn < N) ? src[(size_t)(k0 + kk) * N + c0 + nn] : 0.f; }
    __syncthreads();
    const int n = tid >> 3, kc = tid & 7; const LAS float* s = scr + (8 * kc) * 65 + n;
    u32x4 o; o.x = pk2(s[0], s[65]); o.y = pk2(s[2 * 65], s[3 * 65]); o.z = pk2(s[4 * 65], s[5 * 65]); o.w = pk2(s[6 * 65], s[7 * 65]);
    *(u32x4*)(dst + (size_t)(drow0 + n) * ldd + k0 + 8 * kc) = o;
    __syncthreads();
}
__device__ __forceinline__ void conv_layer(LAS unsigned char* lds, const LayerPtrs& L, int kind, bf16* W, int tid) {
    LAS float* scr = (LAS float*)lds;
    bf16* mix = W + WO_MIX;
    const int n_w1 = 16 * 64, n_w2 = 64 * 16, n_wo = 16 * 16;
    int n_a, n_uq = 0, n_ukv = 0;
    if (kind == 0) n_a = 16 * 24; else if (kind == 1) n_a = 16 * 48; else { n_a = 16 * 12; n_uq = 6 * 24; n_ukv = 4 * 32; }
    const int total = n_w1 + n_w2 + n_wo + n_a + n_uq + n_ukv;
    const int nn = tid & 63, kq = tid >> 6;
#define CJ_DECODE(r_in, SRC, NN, K0, C0, DST, LDD, DR0) do { int r = (r_in); \
        if (r < n_w1) { SRC = L.w1; NN = FF; K0 = (r / 64) * 64; C0 = (r % 64) * 64; DST = W + WO_W1; LDD = D; DR0 = (r % 64) * 64; } \
        else if ((r -= n_w1) < n_w2) { SRC = L.w2; NN = D; K0 = (r / 16) * 64; C0 = (r % 16) * 64; DST = W + WO_W2; LDD = FF; DR0 = (r % 16) * 64; } \
        else if ((r -= n_w2) < n_wo) { SRC = L.w_o; NN = D; K0 = (r / 16) * 64; C0 = (r % 16) * 64; DST = W + WO_WO; LDD = D; DR0 = (r % 16) * 64; } \
        else if ((r -= n_wo) < n_a) { SRC = L.w_a; LDD = D; \
            if (kind == 0) { const int kt = r / 24, tn = r % 24; NN = 1536; K0 = kt * 64; C0 = tn * 64; DST = tn < 20 ? mix : mix + (size_t)1280 * D; DR0 = tn < 20 ? tn * 64 : (tn - 20) * 64; } \
            else if (kind == 1) { const int kt = r / 48, tn = r % 48; NN = 3072; K0 = kt * 64; C0 = tn * 64; DST = tn < 32 ? mix : mix + (size_t)2048 * D; DR0 = tn < 32 ? tn * 64 : (tn - 32) * 64; } \
            else { const int kt = r / 12, tn = r % 12; NN = 672; K0 = kt * 64; C0 = tn * 64; DST = mix; DR0 = tn * 64; } } \
        else if ((r -= n_a) < n_uq) { const int kt = r / 24, tn = r % 24; SRC = L.w_uq; NN = 1536; K0 = kt * 64; C0 = tn * 64; DST = mix + (size_t)768 * D; LDD = 384; DR0 = tn * 64; } \
        else { r -= n_uq; const int kt = r / 32, tn = r % 32; SRC = L.w_ukv; NN = 2048; K0 = kt * 64; C0 = tn * 64; \
               DST = mix + (size_t)768 * D + (size_t)1536 * 384 + ((tn & 1) ? (size_t)1024 * 256 : 0); LDD = 256; DR0 = (tn >> 1) * 64; } } while (0)
#define CJ_LOAD(V, SRC, NN, K0, C0) do { _Pragma("unroll") for (int i = 0; i < 8; ++i) V[i] = ((C0) + nn < (NN)) ? (SRC)[(size_t)((K0) + kq + 8 * i) * (NN) + (C0) + nn] : 0.f; } while (0)
    int bid_ = blockIdx.x; asm volatile("" : "+s"(bid_));
    const int gsz = gridDim.x;
    int it = (gsz == 256) ? ((bid_ + 128) & 255) : bid_;
    const float* src = nullptr; int N = 0, k0 = 0, c0 = 0, ldd = 0, drow0 = 0; bf16* dst = nullptr;
    float v[8];
    if (it < total) { CJ_DECODE(it, src, N, k0, c0, dst, ldd, drow0); CJ_LOAD(v, src, N, k0, c0); }
    while (it < total) {
#pragma unroll
        for (int i = 0; i < 8; ++i) scr[(kq + 8 * i) * 65 + nn] = v[i];
        const int itn = it + gsz;
        const float* srcn = nullptr; int Nn = 0, k0n = 0, c0n = 0, lddn = 0, drow0n = 0; bf16* dstn = nullptr;
        if (itn < total) { CJ_DECODE(itn, srcn, Nn, k0n, c0n, dstn, lddn, drow0n); CJ_LOAD(v, srcn, Nn, k0n, c0n); }
        __syncthreads();
        { const int n = tid >> 3, kc = tid & 7; const LAS float* sp = scr + (8 * kc) * 65 + n;
          u32x4 o; o.x = pk2(sp[0], sp[65]); o.y = pk2(sp[2 * 65], sp[3 * 65]); o.z = pk2(sp[4 * 65], sp[5 * 65]); o.w = pk2(sp[6 * 65], sp[7 * 65]);
          *(u32x4*)(dst + (size_t)(drow0 + n) * ldd + k0 + 8 * kc) = o; }
        __syncthreads();
        it = itn; src = srcn; N = Nn; k0 = k0n; c0 = c0n; dst = dstn; ldd = lddn; drow0 = drow0n;
    }
#undef CJ_DECODE
#undef CJ_LOAD
}
__device__ __forceinline__ void mods_phase(LAS unsigned char* lds, const Params& p, float* mods, int tid) {
    LAS float* sc = (LAS float*)lds;
    LAS float* red = (LAS float*)(lds + 9 * 1024 * 4);
    for (int idx = tid; idx < 9 * 1024; idx += NTHREADS) { const int bb = idx >> 10, k = idx & 1023; const float v = bb < 8 ? p.c[bb * 1024 + k] : p.c_ctx[k]; sc[idx] = v / (1.f + __expf(-v)); }
    __syncthreads();
    const int col = tid & 63, kg = tid >> 6;
    int bid_ = blockIdx.x; asm volatile("" : "+s"(bid_));
    for (int it = bid_; it < 4 * 96; it += gridDim.x) {
        const int l = it / 96, n0 = (it % 96) * 64;
        const float* aw = p.L[l].ada_w; const float* ab = p.L[l].ada_b;
        float acc[9];
#pragma unroll
        for (int bb = 0; bb < 9; ++bb) acc[bb] = 0.f;
        const float* wp = aw + (size_t)(kg * 128) * 6144 + n0 + col;
#pragma unroll 32
        for (int k = 0; k < 128; ++k) { const float w = wp[(size_t)k * 6144];
#pragma unroll
            for (int bb = 0; bb < 9; ++bb) acc[bb] += sc[bb * 1024 + kg * 128 + k] * w; }
#pragma unroll
        for (int bb = 0; bb < 9; ++bb) red[(kg * 9 + bb) * 64 + col] = acc[bb];
        __syncthreads();
        for (int o = tid; o < 576; o += NTHREADS) { const int bb = o >> 6, c = o & 63; float s = 0.f;
#pragma unroll
            for (int g = 0; g < 8; ++g) s += red[(g * 9 + bb) * 64 + c];
            mods[(size_t)l * MODS_PER_LAYER + bb * 6144 + n0 + c] = s + ab[n0 + c]; }
        __syncthreads();
    }
}
__device__ __forceinline__ void tables_phase(float* tab64, float* tab32) {
    const int g = blockIdx.x * NTHREADS + threadIdx.x;
    if (g < 1024) { const int pos = g >> 4, i = g & 15; const float inv = powf(10000.f, -(float)i / 16.f); const float a = (float)pos * inv; tab64[2 * g] = cosf(a); tab64[2 * g + 1] = sinf(a); }
    else if (g < 1536) { const int h = g - 1024; const int pos = h >> 3, i = h & 7; const float inv = powf(10000.f, -(float)i / 8.f); const float a = (float)pos * inv; tab32[2 * h] = cosf(a); tab32[2 * h + 1] = sinf(a); }
}

constexpr int REP_A = 1, REP_B = 1, REP_C = 1, REP_MLP = 1, REP_SYNC = 0, REP_P1 = 1, REP_P0 = 1;
template <class Epi> __device__ __forceinline__ void run_gemm(LAS unsigned char* lds, const bf16* A, int lda, const bf16* Bt, int ldb, int M, int N, int K, const Epi& E, int cidx = -1) {
    pg8::Gemm g{A, Bt, M, N, K, lda, ldb}; int bid_ = blockIdx.x, gd_ = gridDim.x; asm volatile("" : "+s"(bid_), "+s"(gd_)); pg8::StaticOrder S; S.init(M, N, gd_, cidx >= 0 ? cidx : bid_);
    pg8::gemm_phase<Epi, pg8::StaticOrder, true, true>((PG8_LAS unsigned char*)lds, g, S, E);
}

__global__ void __launch_bounds__(NTHREADS, 2) fwd_megakernel(Params p) {
    extern __shared__ __attribute__((aligned(16))) unsigned char lds_raw[];
    LAS unsigned char* lds = (LAS unsigned char*)lds_raw;
    cg::grid_group grid = cg::this_grid();
    volatile LAS unsigned* xb_st = (volatile LAS unsigned*)(lds + 139264);
    if (threadIdx.x == 0) { xb_st[0] = 0u; xb_st[1] = 0u; }
    __syncthreads();
    (void)xcd_barrier_post((unsigned*)(p.ws + WS_XBAR), xb_st);
#define GSYNC() do { size_t zb_ = 0; asm volatile("" : "+s"(zb_)); XcdBarrier xb_; xb_.bar = (unsigned*)(p.ws + WS_XBAR + zb_); xb_.x = xb_xcc_id(); xb_.st = (volatile LAS unsigned*)(lds + 139264); xcd_barrier(xb_); } while (0)
    int tid, lane, wave, gw; const int ngw = gridDim.x * NWAVES;
#define FRESH() do { int t_ = threadIdx.x; asm volatile("" : "+v"(t_)); tid = t_; lane = tid & 63; wave = __builtin_amdgcn_readfirstlane(tid >> 6); int b_ = blockIdx.x; asm volatile("" : "+s"(b_)); gw = b_ * NWAVES + wave; } while (0)
#define DERIVE() size_t z_ = 0; asm volatile("" : "+s"(z_)); unsigned char* ws = p.ws + z_; \
    float* tab64 = (float*)(ws + WS_TAB); float* tab32 = (float*)(ws + WS_TAB + 8192); float* mods = (float*)(ws + WS_MODS); float* HC = (float*)(ws + WS_HC); \
    bf16* KR = (bf16*)(ws + WS_KR); bf16* U = (bf16*)(ws + WS_U); bf16* Y = (bf16*)(ws + WS_Y); bf16* BIG = (bf16*)(ws + WS_BIG); \
    (void)tab64; (void)tab32; (void)mods; (void)HC; (void)KR; (void)U; (void)Y; (void)BIG
#define DERIVE_L() DERIVE(); bf16* W = (bf16*)(ws + WS_W + (size_t)(l & 1) * WS_WSTRIDE); bf16* mix = W + WO_MIX; const float* modsl = mods + (size_t)l * MODS_PER_LAYER; (void)mix; (void)modsl
    FRESH();
    for (int rep = 0; rep < REP_P0; ++rep) { DERIVE();
      tables_phase(tab64, tab32);
      mods_phase(lds, p, mods, tid);
      conv_layer(lds, p.L[0], 0, (bf16*)(ws + WS_W), tid); }
    if (p.ws == nullptr) grid.sync();
    GSYNC(); FRESH();
    for (int rep = 0; rep < REP_SYNC; ++rep) GSYNC();
    for (int rep = 0; rep < REP_P1; ++rep) { DERIVE(); post_pass(gw, ngw, lane, nullptr, nullptr, nullptr, 0, p.x, p.ctx, nullptr, nullptr, U, p.L[0].norms, mods, 0, 1, MT); }
    GSYNC(); FRESH();

#pragma unroll 1
    for (int l = 0; l < 4; ++l) {
        const int kind = l % 3;
        if (kind == 0) {
            { DERIVE_L(); bf16* Qb = BIG; bf16* Kb = BIG + (size_t)MT * 1024; bf16* Vt = Kb + (size_t)MT * 256;
              { pg8::EpiRope<0> E{Qb, 1024, 1024, Kb, 256, 0.125f * LOG2E, tab64, TL}; run_gemm(lds, U, D, mix, D, MT, 1280, D, E); }
              { pg8::EpiStore E{Vt, MT, 0, nullptr, 0, 0}; run_gemm(lds, mix + (size_t)1280 * D, D, U, D, 256, MT, D, E); } }
            GSYNC(); FRESH();
            { DERIVE_L(); bf16* Qb = BIG; bf16* Kb = BIG + (size_t)MT * 1024; bf16* Vt = Kb + (size_t)MT * 256;
              for (int rep = 0; rep < REP_A; ++rep) attn_phase<64, 64, true, true>(lds, Qb, 1024, Kb, 256, 2, nullptr, Vt, 2, U, 1024, p.L[l].x0, 2048, 128); }
            GSYNC(); FRESH();
        } else if (kind == 1) {
            { DERIVE_L(); bf16* Qb = BIG; bf16* Kb = BIG + (size_t)MT * 1024; bf16* Vt = Kb + (size_t)MT * 1024;
              { pg8::EpiRope<0> E{Qb, 1024, 1024, Kb, 1024, 0.125f * LOG2E, tab64, TL}; run_gemm(lds, U, D, mix, D, MT, 2048, D, E); }
              { pg8::EpiStore E{Vt, MT, 0, nullptr, 0, 0}; run_gemm(lds, mix + (size_t)2048 * D, D, U, D, 1024, MT, D, E, (int)((blockIdx.x + 256 - 64) & 255)); } }
            GSYNC(); FRESH();
            { DERIVE_L(); bf16* Qb = BIG; bf16* Kb = BIG + (size_t)MT * 1024; bf16* Vt = Kb + (size_t)MT * 1024;
              for (int rep = 0; rep < REP_B; ++rep) attn_phase<64, 128, false>(lds, Qb, 1024, Kb, 1024, 0, nullptr, Vt, 1, U  , 2048, nullptr, 2048, 128); }
            GSYNC(); FRESH();
            { DERIVE_L(); diff_combine(gw, ngw, lane, U, BIG, p.L[l].x0, p.L[l].x1, 0.8f - 0.6f * 0.7408182206817179f); }
            GSYNC(); FRESH();
        } else {
            { DERIVE_L(); pg8::EpiStore E{Y, 768, 0, nullptr, 0, 0}; run_gemm(lds, U, D, mix, D, MT, 768, D, E); }
            GSYNC(); FRESH();
            { DERIVE_L(); mla_norm(gw, ngw, lane, Y, KR, p.L[l].x0, p.L[l].x1, tab32); }
            GSYNC(); FRESH();
            { DERIVE_L(); bf16* CQ = Y; bf16* Qb = BIG; bf16* Kn = BIG + (size_t)MT * 1536; bf16* Vt = Kn + (size_t)MT * 1024;
              const bf16* Wuq = mix + (size_t)768 * D; const bf16* Wkn = Wuq + (size_t)1536 * 384; const bf16* Wv = Wkn + (size_t)1024 * 256;
              { pg8::EpiRope<1> E{Qb, 1536, 0, nullptr, 0, 0.10206207261596575f * LOG2E, tab32, TL}; run_gemm(lds, CQ, 768, Wuq, 384, MT, 1536, 384, E); }
              { pg8::EpiStore E{Kn, 1024, 0, nullptr, 0, 0}; run_gemm(lds, CQ + 384, 768, Wkn, 256, MT, 1024, 256, E, (int)((blockIdx.x + 256 - 48) & 255)); }
              { pg8::EpiStore E{Vt, MT, 0, nullptr, 0, 0}; run_gemm(lds, Wv, 256, CQ + 384, 768, 1024, MT, 256, E, (int)((blockIdx.x + 256 - 80) & 255)); } }
            GSYNC(); FRESH();
            { DERIVE_L(); bf16* Qb = BIG; bf16* Kn = BIG + (size_t)MT * 1536; bf16* Vt = Kn + (size_t)MT * 1024;
              for (int rep = 0; rep < REP_C; ++rep) attn_phase<96, 64, false>(lds, Qb, 1536, Kn, 1024, 0, KR, Vt, 0, U, 1024, nullptr, 2048, 128); }
            GSYNC(); FRESH();
        }
        { DERIVE_L(); const bf16* attn_out = (kind == 1) ? BIG : U; const float* nr = p.L[l].norms;
          { pg8::EpiFuse E{(l == 0) ? p.x : p.out, p.out, U, nr + D, modsl + 2 * D, nr + 2 * D, modsl + 4 * D, modsl + 3 * D,
                           (float*)(ws + WS_XBUF), (unsigned*)(ws + WS_XCNT), 16u * (unsigned)(2 * (2 * l) + 1), (PG8_LAS unsigned char*)(lds + 131072), EPS};
            run_gemm(lds, attn_out, D, W + WO_WO, D, TL, D, D, E); }
          if (l < 3) {
              int kc = blockIdx.x >> 5; asm volatile("" : "+s"(kc)); const int kcc = kc < 4 ? kc : 0;
              pg8::EpiStore E{(bf16*)(ws + WS_YP) + (size_t)kcc * TC * D, D, 0, nullptr, 0, 0};
              run_gemm(lds, attn_out + (size_t)TL * D + kcc * 256, D, W + WO_WO + kcc * 256, D, TC, D, 256, E, kc < 4 ? (int)(blockIdx.x & 31) : (1 << 20)); } }
        GSYNC(); FRESH();
        if (l < 3) {
            { DERIVE_L(); const float* nr = p.L[l].norms;
              post_pass(gw, ngw, lane, Y, nr + D, modsl, 2, p.out, (l == 0) ? p.ctx : HC, p.out, HC, U, nr + 2 * D, modsl, 3, 4, MT, (const bf16*)(ws + WS_YP), 4, TL); }
            GSYNC(); FRESH();
        }
        { DERIVE_L(); pg8::EpiStore E{BIG, FF, 0, nullptr, 0, 1}; run_gemm(lds, U, D, W + WO_W1, D, l < 3 ? MT : TL, FF, D, E); }
        GSYNC(); FRESH();
        { DERIVE_L(); const int ln_ = l < 3 ? l + 1 : l;
          { pg8::EpiFuse E{p.out, p.out, l < 3 ? U : nullptr, p.L[l].norms + 3 * D, modsl + 5 * D, p.L[ln_].norms, modsl + MODS_PER_LAYER + 1 * D, modsl + MODS_PER_LAYER,
                           (float*)(ws + WS_XBUF), (unsigned*)(ws + WS_XCNT), 16u * (unsigned)(2 * (2 * l + 1) + 1), (PG8_LAS unsigned char*)(lds + 131072), EPS};
            run_gemm(lds, BIG, FF, W + WO_W2, FF, TL, D, FF, E); }
          if (l < 3) {
              int kc = blockIdx.x >> 5; asm volatile("" : "+s"(kc)); const int kcc = kc & 7;
              pg8::EpiStore E{(bf16*)(ws + WS_YP) + (size_t)kcc * TC * D, D, 0, nullptr, 0, 0};
              run_gemm(lds, BIG + (size_t)TL * FF + kcc * 512, FF, W + WO_W2 + kcc * 512, FF, TC, D, 512, E, (int)(blockIdx.x & 31)); } }
        if (l < 3) {
            GSYNC(); FRESH();
            { DERIVE_L(); post_pass(gw, ngw, lane, Y, p.L[l].norms + 3 * D, modsl, 5, p.out, HC, p.out, HC, U, p.L[l + 1].norms, modsl + MODS_PER_LAYER, 0, 1, MT, (const bf16*)(ws + WS_YP), 8, TL);
              conv_layer(lds, p.L[l + 1], (l + 1) % 3, (bf16*)(ws + WS_W + (size_t)((l + 1) & 1) * WS_WSTRIDE), tid); }
            GSYNC(); FRESH();
        }
    }
}

extern "C" void kernel_launch(void* const* d_in, const int* in_sizes, int n_in, void* d_out, int out_size, void* d_ws, size_t ws_size, hipStream_t stream) {
    static int grid = 0;
    if (grid == 0) {
        if (n_in != 40 || ws_size < WS_END || out_size != TL * D) { fprintf(stderr, "kernel_launch: unexpected shapes n_in %d ws %zu out %d\n", n_in, ws_size, out_size); grid = -1; return; }
        int dev = 0, cus = 0, per_cu = 0;
        hipGetDevice(&dev); hipDeviceGetAttribute(&cus, hipDeviceAttributeMultiprocessorCount, dev);
        if (hipFuncSetAttribute((const void*)fwd_megakernel, hipFuncAttributeMaxDynamicSharedMemorySize, LDS_BYTES) != hipSuccess) { fprintf(stderr, "hipFuncSetAttribute failed\n"); grid = -1; return; }
        if (hipOccupancyMaxActiveBlocksPerMultiprocessor(&per_cu, (const void*)fwd_megakernel, NTHREADS, LDS_BYTES) != hipSuccess || per_cu < 1) { fprintf(stderr, "occupancy query: %d\n", per_cu); per_cu = 1; }
        (void)hipGetLastError();
        grid = cus * 1;
    }
    if (grid < 0) return;
    Params p{};
    p.x = (const float*)d_in[0]; p.c = (const float*)d_in[1]; p.ctx = (const float*)d_in[2]; p.c_ctx = (const float*)d_in[3];
    p.out = (float*)d_out; p.ws = (unsigned char*)d_ws;
    auto F = [&](int i) { return (const float*)d_in[i]; };
    p.L[0] = LayerPtrs{F(4), F(5), F(6), F(7), F(9), F(10), F(11), F(8), nullptr, nullptr, nullptr};
    p.L[1] = LayerPtrs{F(12), F(13), F(14), F(15), F(18), F(19), F(20), F(16), F(17), nullptr, nullptr};
    p.L[2] = LayerPtrs{F(21), F(22), F(23), F(24), F(29), F(30), F(31), F(25), F(26), F(27), F(28)};
    p.L[3] = LayerPtrs{F(32), F(33), F(34), F(35), F(37), F(38), F(39), F(36), nullptr, nullptr, nullptr};
    (void)hipMemsetAsync((char*)d_ws + WS_XBAR, 0, WS_XCNT + 128 * 256 - WS_XBAR, stream);
    void* args[] = {&p};
    hipError_t e = hipLaunchCooperativeKernel((const void*)fwd_megakernel, dim3(grid), dim3(NTHREADS), args, LDS_BYTES, stream);
    if (e != hipSuccess) fprintf(stderr, "cooperative launch failed: %s (grid %d)\n", hipGetErrorString(e), grid);
}
```

```cpp
#include <hip/hip_runtime.h>
#include <hip/hip_cooperative_groups.h>
#include <cstdio>
#include <cstdint>
namespace cg = cooperative_groups;
namespace pg8 {
#define PG8_LAS __attribute__((address_space(3)))
typedef unsigned short bf16_t;
typedef short bf16x8 __attribute__((ext_vector_type(8)));
typedef float f32x4 __attribute__((ext_vector_type(4)));
typedef unsigned u32x4 __attribute__((ext_vector_type(4)));
constexpr int BM = 256, BK = 64, HALF = 128, HTB = HALF * BK * 2  , STAGE_BYTES = 8 * HTB, NXCD = 8, WGM = 8;

__host__ __device__ __forceinline__ int lds_byte(int r, int c) { const int st = (r >> 4) * 2 + (c >> 5), rr = r & 15, cc = c & 31, ob = rr * 64 + cc * 2; return st * 1024 + (ob ^ (((ob >> 9) & 1) << 5)); }
__host__ __device__ __forceinline__ void stage_rc(int b, int& R, int& C) { const int st = b / 1024, sb = b % 1024, swz = sb ^ (((sb >> 9) & 1) << 5); R = (st >> 1) * 16 + swz / 64; C = (st & 1) * 32 + (swz % 64) / 2; }
__host__ __device__ __forceinline__ int perm32(int rho) { const int n = rho >> 4, i = rho & 15; return 8 * (i >> 2) + 4 * n + (i & 3); }

struct Unit { int pm, pn; };
struct Gemm { const bf16_t* A; const bf16_t* Bt; int M, N, K, lda, ldb; };

struct StaticOrder {
    int nM, nN, nwg, G, c;
    __host__ __device__ void init(int M, int N, int G_, int c_) { nM = M / BM; nN = N / BM; nwg = nM * nN; G = G_; c = c_; }
    __host__ __device__ bool next(int i, Unit& u) const {
        const int L = i * G + c; if (L >= nwg) return false;
        int wgid = L; { const int q = nwg / NXCD, r = nwg % NXCD, xcd = wgid % NXCD, off = wgid / NXCD; wgid = (xcd < r ? xcd * (q + 1) : r * (q + 1) + (xcd - r) * q) + off; }
        const int nig = WGM * nN, gid = wgid / nig, fm = gid * WGM, gsz = (nM - fm) < WGM ? (nM - fm) : WGM;
        u.pm = fm + ((wgid % nig) % gsz); u.pn = (wgid % nig) / gsz; return true;
    }
    __device__ __forceinline__ void a_ready(const Unit&) const {}
    __device__ __forceinline__ void done(const Unit&) const {}
};

__device__ __forceinline__ unsigned cvt_pk_bf16(float lo, float hi) { unsigned r; asm volatile("v_cvt_pk_bf16_f32 %0, %1, %2" : "=v"(r) : "v"(lo), "v"(hi)); return r; }
typedef float f32x2 __attribute__((ext_vector_type(2)));
__device__ __forceinline__ unsigned pk2e(float lo, float hi) { typedef float v2f __attribute__((ext_vector_type(2))); typedef __bf16 v2b __attribute__((ext_vector_type(2))); v2f v = {lo, hi}; v2b b = __builtin_convertvector(v, v2b); return __builtin_bit_cast(unsigned, b); }
struct EpiStore {
    static constexpr bool PERM = true, AFTER_DRAIN = false;
    bf16_t* O0; int ld0; int split_col; bf16_t* O1; int ld1; int act;
    __device__ __forceinline__ void operator()(const f32x4 (&acc)[2][2][4][2], const Unit& u, int wr, int wc, int fr_, int fq_) const {
        int ln_ = threadIdx.x & 63; asm volatile("" : "+v"(ln_)); const int fr = ln_ & 15, fq = ln_ >> 4; (void)fr_; (void)fq_;
        const int row0 = u.pm * BM + wr * 64 + fr; int colt = u.pn * BM; bf16_t* base = O0; int ld = ld0;
        if (split_col && colt >= split_col) { base = O1; ld = ld1; colt -= split_col; }
        const int col0 = colt + wc * 32 + 8 * fq;
#pragma unroll
        for (int ai = 0; ai < 2; ++ai)
#pragma unroll
            for (int m = 0; m < 4; ++m) { bf16_t* rowp = base + (size_t)(row0 + ai * HALF + m * 16) * ld + col0;
#pragma unroll
                for (int bj = 0; bj < 2; ++bj) { f32x4 v0 = acc[ai][bj][m][0], v1 = acc[ai][bj][m][1];
                    if (act) {
#pragma unroll
                        for (int e = 0; e < 4; ++e) { float a = v0[e] > 0.f ? v0[e] : 0.f; v0[e] = a * a; float b = v1[e] > 0.f ? v1[e] : 0.f; v1[e] = b * b; } }
                    u32x4 w; w.x = pk2e(v0[0], v0[1]); w.y = pk2e(v0[2], v0[3]); w.z = pk2e(v1[0], v1[1]); w.w = pk2e(v1[2], v1[3]);
                    *(u32x4*)(rowp + bj * HALF) = w; } }
    }
};
template <int MODE> struct EpiRope {
    static constexpr bool PERM = false, AFTER_DRAIN = false;
    bf16_t* O0; int ld0; int split_col; bf16_t* O1; int ld1; float qscale; const float* tab; int tlat;
    __device__ __forceinline__ void operator()(const f32x4 (&acc)[2][2][4][2], const Unit& u, int wr, int wc, int fr_, int fq_) const {
        int ln_ = threadIdx.x & 63; asm volatile("" : "+v"(ln_)); const int fr = ln_ & 15, fq = ln_ >> 4; (void)fr_; (void)fq_;
        typedef unsigned u32x2v __attribute__((ext_vector_type(2)));
        int colt = u.pn * BM; bf16_t* base = O0; int ld = ld0; float sc = qscale;
        const int gcolt = colt;
        if (split_col && colt >= split_col) { base = O1; ld = ld1; colt -= split_col; sc = 1.f; }
#pragma unroll
        for (int ai = 0; ai < 2; ++ai)
#pragma unroll
            for (int m = 0; m < 4; ++m) {
                const int row = u.pm * BM + ai * HALF + wr * 64 + m * 16 + fr;
                const bool lat = row < tlat; const int s = row & 4095, prow = s >> 6, pcol = s & 63;
                bf16_t* rowp = base + (size_t)row * ld + colt + wc * 32 + 4 * fq;
#pragma unroll
                for (int bj = 0; bj < 2; ++bj) {
                    if (MODE == 0) {
                        const int pos = (wc & 1) ? pcol : prow;
                        const f32x4* tp = (const f32x4*)(tab + (size_t)(pos * 16 + 4 * fq) * 2);
                        const f32x4 t0 = tp[0], t1 = tp[1];
                        const f32x4 x1 = acc[ai][bj][m][0], x2 = acc[ai][bj][m][1];
                        const float cs[4] = {t0[0], t0[2], t1[0], t1[2]}, sn[4] = {t0[1], t0[3], t1[1], t1[3]};
                        float o1[4], o2[4];
#pragma unroll
                        for (int e = 0; e < 4; ++e) { o1[e] = lat ? x1[e] * cs[e] - x2[e] * sn[e] : x1[e]; o2[e] = lat ? x2[e] * cs[e] + x1[e] * sn[e] : x2[e]; o1[e] *= sc; o2[e] *= sc; }
                        u32x2v w1, w2; w1.x = pk2e(o1[0], o1[1]); w1.y = pk2e(o1[2], o1[3]); w2.x = pk2e(o2[0], o2[1]); w2.y = pk2e(o2[2], o2[3]);
                        *(u32x2v*)(rowp + bj * HALF) = w1; *(u32x2v*)(rowp + bj * HALF + 16) = w2;
                    } else {
#pragma unroll
                        for (int n = 0; n < 2; ++n) {
                            const int c0 = gcolt + bj * HALF + wc * 32 + 16 * n; const int cc = c0 % 96;
                            const f32x4 x = acc[ai][bj][m][n]; float o[4] = {x[0], x[1], x[2], x[3]};
                            if (cc >= 64) {
                                const int pos = (cc >= 80) ? pcol : prow;
                                const f32x4* tp = (const f32x4*)(tab + (size_t)(pos * 8 + 4 * (fq & 1)) * 2);
                                const f32x4 t0 = tp[0], t1 = tp[1];
                                const float cs[4] = {t0[0], t0[2], t1[0], t1[2]}, sn[4] = {t0[1], t0[3], t1[1], t1[3]};
#pragma unroll
                                for (int e = 0; e < 4; ++e) { const float p = __shfl_xor(x[e], 32); const float r = (fq < 2) ? x[e] * cs[e] - p * sn[e] : x[e] * cs[e] + p * sn[e]; o[e] = lat ? r : x[e]; }
                            }
                            u32x2v w; w.x = pk2e(o[0] * sc, o[1] * sc); w.y = pk2e(o[2] * sc, o[3] * sc);
                            *(u32x2v*)(rowp + bj * HALF + 16 * n) = w;
                        }
                    }
                }
            }
    }
};
__device__ __forceinline__ float epi_shx(float v, int o, int lane) { return __int_as_float(__builtin_amdgcn_ds_bpermute((lane ^ o) << 2, __float_as_int(v))); }
struct EpiFuse {
    static constexpr bool PERM = true, AFTER_DRAIN = false;
    const float* hin; float* hout; bf16_t* U;
    const float* gY; const float* gate; const float* gU; const float* scale; const float* shift;
    float* X; unsigned* cnt; unsigned target0; PG8_LAS unsigned char* scr; float eps;
    __device__ __forceinline__ void xchg(const float (&ss)[2][4], float (&rs)[2][4], const Unit& u, int wr, int wc, int fr, int fq, int tid, int which) const {
        PG8_LAS float* P = (PG8_LAS float*)scr; PG8_LAS float* S = (PG8_LAS float*)(scr + 4096);
        if (fq == 0) {
#pragma unroll
            for (int ai = 0; ai < 2; ++ai)
#pragma unroll
                for (int m = 0; m < 4; ++m) P[(ai * 128 + wr * 64 + m * 16 + fr) * 4 + wc] = ss[ai][m]; }
        asm volatile("s_waitcnt lgkmcnt(0)" ::: "memory"); __builtin_amdgcn_s_barrier(); asm volatile("" ::: "memory");
        float* Xe = X + (size_t)which * (128 * 4 * 256) + (size_t)u.pm * 1024;
        unsigned* c = cnt + 64 * u.pm;
        if (tid < 256) { const f32x4 p = *(const PG8_LAS f32x4*)(P + tid * 4);
            __hip_atomic_store(Xe + u.pn * 256 + tid, (p[0] + p[1]) + (p[2] + p[3]), __ATOMIC_RELAXED, __HIP_MEMORY_SCOPE_AGENT); }
        asm volatile("s_waitcnt vmcnt(0)" ::: "memory");
        if (tid < 256 && (tid & 63) == 0) __hip_atomic_fetch_add(c, 1u, __ATOMIC_RELAXED, __HIP_MEMORY_SCOPE_AGENT);
        if (tid < 64) { const unsigned want = target0 + 16u * (unsigned)which; unsigned spins = 0;
            while ((unsigned)__builtin_amdgcn_readfirstlane(__hip_atomic_load(c, __ATOMIC_RELAXED, __HIP_MEMORY_SCOPE_AGENT)) < want) { __builtin_amdgcn_s_sleep(1); if (++spins > (1u << 20)) break; }
            __builtin_amdgcn_fence(__ATOMIC_ACQUIRE, "agent"); }
        asm volatile("s_waitcnt vmcnt(0) lgkmcnt(0)" ::: "memory"); __builtin_amdgcn_s_barrier(); asm volatile("" ::: "memory");
        if (tid < 256) { float t = 0.f;
#pragma unroll
            for (int q = 0; q < 4; ++q) t += __hip_atomic_load(Xe + q * 256 + tid, __ATOMIC_RELAXED, __HIP_MEMORY_SCOPE_AGENT);
            S[tid] = 1.0f / sqrtf(t * (1.f / 1024.f) + eps); }
        asm volatile("s_waitcnt vmcnt(0) lgkmcnt(0)" ::: "memory"); __builtin_amdgcn_s_barrier(); asm volatile("" ::: "memory");
#pragma unroll
        for (int ai = 0; ai < 2; ++ai)
#pragma unroll
            for (int m = 0; m < 4; ++m) rs[ai][m] = S[ai * 128 + wr * 64 + m * 16 + fr];
        asm volatile("s_waitcnt lgkmcnt(0)" ::: "memory");
    }
    __device__ __forceinline__ void operator()(f32x4 (&acc)[2][2][4][2], const Unit& u, int wr, int wc, int fr_, int fq_) const {
        int tid = threadIdx.x; asm volatile("" : "+v"(tid)); const int ln = tid & 63, fr = ln & 15, fq = ln >> 4; (void)fr_; (void)fq_;
        const int b = (u.pm * BM) >> 12; const int colb = u.pn * BM + wc * 32 + 8 * fq; const int row0 = u.pm * BM + wr * 64 + fr;
        float ss[2][4], rs[2][4];
#pragma unroll
        for (int ai = 0; ai < 2; ++ai)
#pragma unroll
            for (int m = 0; m < 4; ++m) { float s = 0.f;
#pragma unroll
                for (int bj = 0; bj < 2; ++bj)
#pragma unroll
                    for (int n = 0; n < 2; ++n) { const f32x4 v = acc[ai][bj][m][n]; s += (v[0] * v[0] + v[1] * v[1]) + (v[2] * v[2] + v[3] * v[3]); }
                s += epi_shx(s, 16, ln); s += epi_shx(s, 32, ln); ss[ai][m] = s; }
        f32x4 H[2][2][2];
#define EF_LOADH(ai_, mp_) do { _Pragma("unroll") for (int mm = 0; mm < 2; ++mm) { const size_t ro_ = (size_t)(row0 + (ai_) * HALF + (2 * (mp_) + mm) * 16) * 1024 + colb; \
            _Pragma("unroll") for (int bj = 0; bj < 2; ++bj) _Pragma("unroll") for (int n = 0; n < 2; ++n) H[mm][bj][n] = *(const f32x4*)(hin + ro_ + bj * HALF + 4 * n); } } while (0)
        EF_LOADH(0, 0);
        xchg(ss, rs, u, wr, wc, fr, fq, tid, 0);
        { f32x4 G[2][2];
#pragma unroll
          for (int bj = 0; bj < 2; ++bj)
#pragma unroll
              for (int n = 0; n < 2; ++n) G[bj][n] = *(const f32x4*)(gate + (size_t)b * 6144 + colb + bj * HALF + 4 * n) * *(const f32x4*)(gY + colb + bj * HALF + 4 * n);
#pragma unroll
          for (int ai = 0; ai < 2; ++ai)
#pragma unroll
              for (int mp = 0; mp < 2; ++mp) {
                  if (ai + mp > 0) EF_LOADH(ai, mp);
#pragma unroll
                  for (int mm = 0; mm < 2; ++mm) { const int m = 2 * mp + mm; const size_t ro = (size_t)(row0 + ai * HALF + m * 16) * 1024 + colb; float s = 0.f;
#pragma unroll
                      for (int bj = 0; bj < 2; ++bj)
#pragma unroll
                          for (int n = 0; n < 2; ++n) { const f32x4 v = H[mm][bj][n] + G[bj][n] * (acc[ai][bj][m][n] * rs[ai][m]);
                              *(f32x4*)(hout + ro + bj * HALF + 4 * n) = v; acc[ai][bj][m][n] = v; s += (v[0] * v[0] + v[1] * v[1]) + (v[2] * v[2] + v[3] * v[3]); }
                      s += epi_shx(s, 16, ln); s += epi_shx(s, 32, ln); ss[ai][m] = s; } } }
#undef EF_LOADH
        if (U) {
            xchg(ss, rs, u, wr, wc, fr, fq, tid, 1);
            f32x4 A2[2][2], B2[2][2];
#pragma unroll
            for (int bj = 0; bj < 2; ++bj)
#pragma unroll
                for (int n = 0; n < 2; ++n) { A2[bj][n] = *(const f32x4*)(gU + colb + bj * HALF + 4 * n) * (*(const f32x4*)(scale + (size_t)b * 6144 + colb + bj * HALF + 4 * n) + 1.f);
                    B2[bj][n] = *(const f32x4*)(shift + (size_t)b * 6144 + colb + bj * HALF + 4 * n); }
#pragma unroll
            for (int ai = 0; ai < 2; ++ai)
#pragma unroll
                for (int m = 0; m < 4; ++m) { bf16_t* up = U + (size_t)(row0 + ai * HALF + m * 16) * 1024 + colb;
#pragma unroll
                    for (int bj = 0; bj < 2; ++bj) { const f32x4 v0 = (acc[ai][bj][m][0] * rs[ai][m]) * A2[bj][0] + B2[bj][0], v1 = (acc[ai][bj][m][1] * rs[ai][m]) * A2[bj][1] + B2[bj][1];
                        u32x4 w; w.x = pk2e(v0[0], v0[1]); w.y = pk2e(v0[2], v0[3]); w.z = pk2e(v1[0], v1[1]); w.w = pk2e(v1[2], v1[3]); *(u32x4*)(up + bj * HALF) = w; } }
        }
    }
};
template <class Epi, class Sched, bool ALIGN_EPI = false, bool SP2 = false>
__device__ __forceinline__ void gemm_phase(PG8_LAS unsigned char* lds, const Gemm g, const Sched& S, const Epi& E) {
    int tid_l = threadIdx.x; asm volatile("" : "+v"(tid_l)); const int tid = tid_l, wid = __builtin_amdgcn_readfirstlane(tid >> 6), lane = tid & 63, wr = wid >> 2, wc = wid & 3, fr = lane & 15, fq = lane >> 4;
    const int K = g.K, nt = K / BK;
    unsigned voffA[2], voffB[2];
#pragma unroll
    for (int i = 0; i < 2; ++i) { int R, C; stage_rc(tid * 16 + i * 8192, R, C); const int Rb = Epi::PERM ? ((R & ~31) + perm32(R & 31)) : R;
        voffA[i] = (unsigned)(R * g.lda + C) * 2u; voffB[i] = (unsigned)(Rb * g.ldb + C) * 2u; }
    const size_t kstep = (size_t)(BK * 2);
    const size_t hstepA = (size_t)HALF * g.lda * 2, hstepB = (size_t)HALF * g.ldb * 2;
    const size_t tstepA = 2 * hstepA, tstepB = 2 * hstepB;
    const unsigned ldsw = (unsigned)wid * 1024u;
    const int aoff = lds_byte(wr * 64 + fr, fq * 8), boff = lds_byte(wc * 32 + fr, fq * 8);
#define PG8_SA(b, h) (((b) * 2 + (h)) * HTB)
#define PG8_SB(b, h) ((4 + (b) * 2 + (h)) * HTB)
#define PG8_STAGE(bufoff, gbase, voff) do { _Pragma("unroll") for (int _i = 0; _i < 2; ++_i) \
        __builtin_amdgcn_global_load_lds((const unsigned*)((const char*)(gbase) + (voff)[_i]), (PG8_LAS unsigned*)(lds + (bufoff) + ldsw + _i * 8192), 16, 0, 0); } while (0)
#define PG8_LDA(dst, b, h) do { _Pragma("unroll") for (int m = 0; m < 4; ++m) _Pragma("unroll") for (int k = 0; k < 2; ++k) dst[m][k] = *(const PG8_LAS bf16x8*)(lds + PG8_SA(b, h) + aoff + m * 2048 + k * 1024); } while (0)
#define PG8_LDB(dst, b, h) do { _Pragma("unroll") for (int n = 0; n < 2; ++n) _Pragma("unroll") for (int k = 0; k < 2; ++k) dst[n][k] = *(const PG8_LAS bf16x8*)(lds + PG8_SB(b, h) + boff + n * 2048 + k * 1024); } while (0)
#define PG8_MMA(ai, bj, At, Bt) do { __builtin_amdgcn_s_setprio(1); _Pragma("unroll") for (int m = 0; m < 4; ++m) _Pragma("unroll") for (int n = 0; n < 2; ++n) _Pragma("unroll") for (int k = 0; k < 2; ++k) \
        acc[ai][bj][m][n] = __builtin_amdgcn_mfma_f32_16x16x32_bf16(Bt[n][k], At[m][k], acc[ai][bj][m][n], 0, 0, 0); __builtin_amdgcn_s_setprio(0); } while (0)
#define PG8_WAIT_V(n) asm volatile("s_waitcnt vmcnt(" #n ")" ::: "memory")
#define PG8_WAIT_L(n) asm volatile("s_waitcnt lgkmcnt(" #n ")" ::: "memory")
#define PG8_BAR __builtin_amdgcn_s_barrier()
#define PG8_SCHED __builtin_amdgcn_sched_barrier(0)
    Unit cur, nxt; int ui = 0;
    if (!S.next(0, cur)) return;
    f32x4 acc[2][2][4][2];
#pragma unroll
    for (int a = 0; a < 2; ++a)
#pragma unroll
        for (int b = 0; b < 2; ++b)
#pragma unroll
            for (int m = 0; m < 4; ++m)
#pragma unroll
                for (int n = 0; n < 2; ++n) acc[a][b][m][n] = (f32x4){0.f, 0.f, 0.f, 0.f};
    bf16x8 At[4][2], B0[2][2], B1[2][2];
    const char* cA = (const char*)g.A + (size_t)cur.pm * tstepA; const char* cB = (const char*)g.Bt + (size_t)cur.pn * tstepB;
    S.a_ready(cur);
    if constexpr (SP2) {
        PG8_STAGE(PG8_SB(0, 0), cB, voffB); PG8_STAGE(PG8_SB(0, 1), cB + hstepB, voffB); PG8_STAGE(PG8_SA(0, 0), cA, voffA); PG8_STAGE(PG8_SA(0, 1), cA + hstepA, voffA);
        if (wr == 1) PG8_BAR;
        PG8_WAIT_V(2); PG8_BAR;
        PG8_STAGE(PG8_SB(1, 0), cB + kstep, voffB); PG8_STAGE(PG8_SA(1, 0), cA + kstep, voffA); PG8_STAGE(PG8_SB(1, 1), cB + hstepB + kstep, voffB);
        PG8_WAIT_V(6); PG8_BAR;
    } else {
        PG8_STAGE(PG8_SB(0, 0), cB, voffB); PG8_STAGE(PG8_SA(0, 0), cA, voffA); PG8_STAGE(PG8_SB(0, 1), cB + hstepB, voffB); PG8_STAGE(PG8_SA(0, 1), cA + hstepA, voffA);
        if (wr == 1) PG8_BAR;
        PG8_WAIT_V(4); PG8_BAR;
        PG8_STAGE(PG8_SB(1, 0), cB + kstep, voffB); PG8_STAGE(PG8_SA(1, 0), cA + kstep, voffA); PG8_STAGE(PG8_SB(1, 1), cB + hstepB + kstep, voffB);
        PG8_WAIT_V(6); PG8_BAR;
    }
    for (;;) {
        const bool has_next = S.next(ui + 1, nxt);
        const char* nA = has_next ? (const char*)g.A + (size_t)nxt.pm * tstepA : cA; const char* nB = has_next ? (const char*)g.Bt + (size_t)nxt.pn * tstepB : cB;
        for (int t = 0; t < nt; t += 2) {
            const bool last = (t == nt - 2);
            const char* a1 = cA + (size_t)(t + 1) * kstep;
            const char* a2 = last ? nA : cA + (size_t)(t + 2) * kstep; const char* b2 = last ? nB : cB + (size_t)(t + 2) * kstep;
            const char* a3 = a2 + kstep; const char* b3 = b2 + kstep;
            if (last && has_next) S.a_ready(nxt);
            if constexpr (SP2) {
            PG8_LDB(B0, 0, 0); PG8_LDB(B1, 0, 1); PG8_SCHED; PG8_LDA(At, 0, 0); PG8_STAGE(PG8_SA(1, 1), a1 + hstepA, voffA);
            PG8_WAIT_V(8); PG8_WAIT_L(0); PG8_BAR; PG8_MMA(0, 0, At, B0); PG8_MMA(0, 1, At, B1); PG8_BAR; PG8_SCHED;
            PG8_LDA(At, 0, 1); PG8_STAGE(PG8_SB(0, 0), b2, voffB); PG8_STAGE(PG8_SB(0, 1), b2 + hstepB, voffB); PG8_STAGE(PG8_SA(0, 0), a2, voffA);
            PG8_WAIT_V(8); PG8_WAIT_L(0); PG8_BAR; PG8_MMA(1, 0, At, B0); PG8_MMA(1, 1, At, B1); PG8_BAR; PG8_SCHED;
            PG8_LDB(B0, 1, 0); PG8_LDB(B1, 1, 1); PG8_SCHED; PG8_LDA(At, 1, 0); PG8_STAGE(PG8_SA(0, 1), a2 + hstepA, voffA);
            PG8_WAIT_V(8); PG8_WAIT_L(0); PG8_BAR; PG8_MMA(0, 0, At, B0); PG8_MMA(0, 1, At, B1); PG8_BAR; PG8_SCHED;
            PG8_LDA(At, 1, 1); PG8_STAGE(PG8_SB(1, 0), b3, voffB); PG8_STAGE(PG8_SB(1, 1), b3 + hstepB, voffB); PG8_STAGE(PG8_SA(1, 0), a3, voffA);
            PG8_WAIT_V(8); PG8_WAIT_L(0); PG8_BAR; PG8_MMA(1, 0, At, B0); PG8_MMA(1, 1, At, B1); PG8_BAR; PG8_SCHED;
            } else {
            PG8_LDB(B0, 0, 0); PG8_SCHED; PG8_LDA(At, 0, 0); PG8_STAGE(PG8_SA(1, 1), a1 + hstepA, voffA);
            PG8_WAIT_L(8); PG8_BAR; PG8_WAIT_L(0); PG8_MMA(0, 0, At, B0); PG8_BAR; PG8_SCHED;
            PG8_LDB(B1, 0, 1); PG8_STAGE(PG8_SB(0, 0), b2, voffB);
            PG8_BAR; PG8_WAIT_L(0); PG8_MMA(0, 1, At, B1); PG8_BAR;
            PG8_LDA(At, 0, 1); PG8_STAGE(PG8_SA(0, 0), a2, voffA);
            PG8_BAR; PG8_WAIT_L(0); PG8_MMA(1, 0, At, B0); PG8_BAR; PG8_SCHED;
            PG8_STAGE(PG8_SB(0, 1), b2 + hstepB, voffB);
            PG8_WAIT_V(6); PG8_BAR; PG8_MMA(1, 1, At, B1); PG8_BAR;
            PG8_LDB(B0, 1, 0); PG8_SCHED; PG8_LDA(At, 1, 0); PG8_STAGE(PG8_SA(0, 1), a2 + hstepA, voffA);
            PG8_WAIT_L(8); PG8_BAR; PG8_WAIT_L(0); PG8_MMA(0, 0, At, B0); PG8_BAR; PG8_SCHED;
            PG8_LDB(B1, 1, 1); PG8_STAGE(PG8_SB(1, 0), b3, voffB);
            PG8_BAR; PG8_WAIT_L(0); PG8_MMA(0, 1, At, B1); PG8_BAR;
            PG8_LDA(At, 1, 1); PG8_STAGE(PG8_SA(1, 0), a3, voffA);
            PG8_BAR; PG8_WAIT_L(0); PG8_MMA(1, 0, At, B0); PG8_BAR; PG8_SCHED;
            PG8_STAGE(PG8_SB(1, 1), b3 + hstepB, voffB);
            PG8_WAIT_V(6); PG8_BAR; PG8_MMA(1, 1, At, B1); PG8_BAR;
            }
        }
        if constexpr (ALIGN_EPI) { if (wr == 0) PG8_BAR; }
        if constexpr (!Epi::AFTER_DRAIN) { E(acc, cur, wr, wc, fr, fq); S.done(cur); }
        if (!has_next) break;
#pragma unroll
        for (int a = 0; a < 2; ++a)
#pragma unroll
            for (int b = 0; b < 2; ++b)
#pragma unroll
                for (int m = 0; m < 4; ++m)
#pragma unroll
                    for (int n = 0; n < 2; ++n) acc[a][b][m][n] = (f32x4){0.f, 0.f, 0.f, 0.f};
        cur = nxt; cA = nA; cB = nB; ++ui;
        if constexpr (ALIGN_EPI) { if (wr == 1) PG8_BAR; }
    }
    PG8_WAIT_V(0);
    if constexpr (!ALIGN_EPI) { if (wr == 0) PG8_BAR; }
    PG8_BAR;
    if constexpr (Epi::AFTER_DRAIN) { E.fused(acc, cur, wr, wc, fr, fq, lds, wid, lane); S.done(cur); }
#undef PG8_SA
#undef PG8_SB
#undef PG8_STAGE
#undef PG8_LDA
#undef PG8_LDB
#undef PG8_MMA
#undef PG8_WAIT_V
#undef PG8_WAIT_L
#undef PG8_BAR
#undef PG8_SCHED
}
}
#define LAS __attribute__((address_space(3)))
typedef unsigned short bf16;
typedef short bf16x8 __attribute__((ext_vector_type(8)));
typedef float f32x4 __attribute__((ext_vector_type(4)));
typedef float f32x16 __attribute__((ext_vector_type(16)));
typedef unsigned u32x4 __attribute__((ext_vector_type(4)));
typedef unsigned u32x2 __attribute__((ext_vector_type(2)));
typedef float f32x2_t __attribute__((ext_vector_type(2)));
typedef __bf16 bf16x2_t __attribute__((ext_vector_type(2)));

constexpr int D = 1024, NB = 8, SEQ = 4096, CTXL = 256, FF = 4096;
constexpr int TL = NB * SEQ, TC = NB * CTXL, MT = TL + TC;
constexpr float EPS = 1e-6f, LOG2E = 1.4426950408889634f;
constexpr int NTHREADS = 512, NWAVES = 8;
constexpr size_t MiB = 1u << 20;
constexpr size_t WS_TAB = 0;
constexpr size_t WS_XBAR = 32768;
constexpr size_t WS_XCNT = 49152;
constexpr size_t WS_XBUF = 38 * MiB;
constexpr size_t WS_MODS = 1 * MiB;
constexpr size_t WS_HC = 2 * MiB;
constexpr size_t WS_KR = 10 * MiB;
constexpr size_t WS_W = 14 * MiB;
constexpr size_t WS_WSTRIDE = 26 * MiB;
constexpr size_t WS_U = 66 * MiB;
constexpr size_t WS_Y = 134 * MiB;
constexpr size_t WS_BIG = 202 * MiB;
constexpr size_t WS_YP = 474 * MiB;
constexpr size_t WS_END = 506 * MiB;
constexpr size_t WO_W1 = 0, WO_W2 = 4u << 20, WO_WO = 8u << 20, WO_MIX = 9u << 20;
constexpr int LDS_BYTES = 147456;
constexpr int MODS_PER_LAYER = 9 * 6144;

__device__ __forceinline__ unsigned pk2(float lo, float hi) { f32x2_t v = {lo, hi}; bf16x2_t b = __builtin_convertvector(v, bf16x2_t); return __builtin_bit_cast(unsigned, b); }
__device__ __forceinline__ float bflo(unsigned u) { return __uint_as_float(u << 16); }
__device__ __forceinline__ float bfhi(unsigned u) { return __uint_as_float(u & 0xffff0000u); }
__device__ __forceinline__ float shx(float v, int o, int lane) { return __int_as_float(__builtin_amdgcn_ds_bpermute((lane ^ o) << 2, __float_as_int(v))); }
__device__ __forceinline__ float wave_sum(float v, int lane) {
#pragma unroll
    for (int o = 1; o < 64; o <<= 1) v += shx(v, o, lane);
    return v;
}
__device__ __forceinline__ float xor32(float v, int hh) {
    const unsigned u = __float_as_uint(v);
    auto r = __builtin_amdgcn_permlane32_swap(u, u, false, false);
    return __uint_as_float(hh ? r[0] : r[1]);
}

struct LayerPtrs { const float *ada_w, *ada_b, *norms, *w_a, *w_o, *w1, *w2, *x0, *x1, *w_uq, *w_ukv; };
struct Params { const float *x, *c, *ctx, *c_ctx; float* out; unsigned char* ws; LayerPtrs L[4]; };
#define XB_TMO      128
#define XB_XCNT(j)  (256  + 64 * (j))
#define XB_XSUB(j)  (1280 + 64 * (j))
#define XB_XGEN(j)  (2304 + 64 * (j))
#define XB_TOP      3328
#define XB_TOPGEN   3392
#define XCD_BAR_WORDS 3456
#define XB_SPIN_CAP (1u << 18)

__device__ __forceinline__ unsigned xb_ld(unsigned* p)              { return __hip_atomic_load(p, __ATOMIC_RELAXED, __HIP_MEMORY_SCOPE_AGENT); }
__device__ __forceinline__ unsigned xb_add(unsigned* p, unsigned v) { return __hip_atomic_fetch_add(p, v, __ATOMIC_RELAXED, __HIP_MEMORY_SCOPE_AGENT); }
__device__ __forceinline__ unsigned xb_xcc_id() { return (unsigned)__builtin_amdgcn_s_getreg((3 << 11) | 20) & 0xFu; }
#define XB_SPIN(cond, bar) do { unsigned _sp = 0; while (cond) { __builtin_amdgcn_s_sleep(1); \
    if ((++_sp & 255u) == 0u) { if (xb_ld(&(bar)[XB_TMO])) break; if (_sp > XB_SPIN_CAP) { atomicAdd(&(bar)[XB_TMO], 1u); break; } } } } while (0)

struct XcdBarrier {
    unsigned* bar; unsigned x;
    volatile LAS unsigned* st;
};

__device__ __forceinline__ XcdBarrier xcd_barrier_post(unsigned* bar, volatile LAS unsigned* st) {
    XcdBarrier b; b.bar = bar; b.x = xb_xcc_id(); b.st = st;
    if (threadIdx.x == 0) (void)xb_add(&bar[XB_XCNT(b.x)], 1u);
    return b;
}
__device__ __forceinline__ void xcd_barrier_complete(unsigned* bar, unsigned x, unsigned& nloc, unsigned& nx) {
    const unsigned G = gridDim.x * gridDim.y * gridDim.z;
    unsigned sum, cnt, mine, sp = 0u;
    for (;;) {
        sum = 0u; cnt = 0u; mine = 0u;
#pragma unroll
        for (unsigned j = 0; j < 16; ++j) { const unsigned c = xb_ld(&bar[XB_XCNT(j)]); sum += c; cnt += (c > 0u) ? 1u : 0u; mine = (j == x) ? c : mine; }
        if (sum == G) break;
        __builtin_amdgcn_s_sleep(1);
        if ((++sp & 255u) == 0u) { if (xb_ld(&bar[XB_TMO])) break; if (sp > XB_SPIN_CAP) { atomicAdd(&bar[XB_TMO], 1u); break; } }
    }
    nloc = mine > 0u ? mine : 1u; nx = cnt > 0u ? cnt : 1u;
}

__device__ __forceinline__ void xcd_barrier(const XcdBarrier& b) {
    asm volatile("s_waitcnt vmcnt(0)" ::: "memory");
    __syncthreads();
    if (threadIdx.x == 0) {
        unsigned* bar = b.bar;
        __builtin_amdgcn_s_waitcnt(0);
        unsigned nloc = b.st[0], nx = b.st[1];
        if (nloc == 0u) { xcd_barrier_complete(bar, b.x, nloc, nx); b.st[0] = nloc; b.st[1] = nx; }
        const unsigned old = xb_add(&bar[XB_XSUB(b.x)], 1u);
        const unsigned gen = old / nloc;
        if (old + 1u == (gen + 1u) * nloc) {
            __builtin_amdgcn_fence(__ATOMIC_RELEASE, "agent");
            asm volatile("s_waitcnt vmcnt(0)" ::: "memory");
            const unsigned og = xb_add(&bar[XB_TOP], 1u);
            const unsigned tg = og / nx;
            if (og + 1u == (tg + 1u) * nx) xb_add(&bar[XB_TOPGEN], 1u);
            else XB_SPIN(xb_ld(&bar[XB_TOPGEN]) == tg, bar);
            __builtin_amdgcn_fence(__ATOMIC_ACQUIRE, "agent");
            xb_add(&bar[XB_XGEN(b.x)], 1u);
            asm volatile("s_waitcnt vmcnt(0)" ::: "memory");
        } else {
            XB_SPIN(xb_ld(&bar[XB_XGEN(b.x)]) == gen, bar);
            __builtin_amdgcn_fence(__ATOMIC_ACQUIRE, "agent");
            asm volatile("s_waitcnt vmcnt(0)" ::: "memory");
        }
    }
    __syncthreads();
}
constexpr float AT_THR = 24.f;
#define AT_BAR() do { asm volatile("s_waitcnt lgkmcnt(0)" ::: "memory"); __builtin_amdgcn_s_barrier(); asm volatile("" ::: "memory"); } while (0)
constexpr int AT_KB = 12288, AT_VB = 16384, AT_K0 = 0, AT_V0 = 3 * AT_KB;
template <int DQ, int DV, bool WINDOW, bool GQA = false>
__device__ __forceinline__ void attn_phase(LAS unsigned char* lds, const bf16* __restrict__ Q, int ldq, const bf16* __restrict__ K1, int ldk, int kshift,
                                           const bf16* __restrict__ KR, const bf16* __restrict__ Vt, int vshift, bf16* __restrict__ O, int ldo,
                                           const float* __restrict__ sink, int nunits_lat, int nunits_ctx) {
    constexpr int NKS = DQ / 16, NV = DV / 32, KROWB = DQ * 2, NVL = DV / 64, NKL = (DQ == 64) ? 1 : 2;
    int tid_l = threadIdx.x; asm volatile("" : "+v"(tid_l)); const int tid = tid_l, lane = tid & 63, wave = __builtin_amdgcn_readfirstlane(tid >> 6), r32 = lane & 31, hh = lane >> 5;
    int grp;
    { LAS unsigned* cnt = (LAS unsigned*)(lds + 138240);
      if (tid < 4) cnt[tid] = 0u;
      AT_BAR();
      const unsigned simd = (unsigned)__builtin_amdgcn_s_getreg((1 << 11) | (4 << 6) | 4) & 3u;
      unsigned old = 0u; if (lane == 0) old = __hip_atomic_fetch_add(cnt + simd, 1u, __ATOMIC_RELAXED, __HIP_MEMORY_SCOPE_WORKGROUP);
      grp = (int)(__builtin_amdgcn_readfirstlane(old) & 1u);
      AT_BAR(); }
    const int pk = (r32 & ~0xC) | ((r32 & 4) << 1) | ((r32 & 8) >> 1);
    int koff[NKS];
#pragma unroll
    for (int ks = 0; ks < NKS; ++ks) { const int c = 2 * ks + hh; const int sw = (DQ == 64) ? ((pk >> 1) & 7) : ((pk >> 2) & 3); koff[ks] = pk * KROWB + ((c ^ sw) << 4); }
    int voff[4];
#pragma unroll
    for (int ts = 0; ts < 4; ++ts) voff[ts] = r32 * 128 + (((2 * ts + hh) ^ ((r32 >> 1) & 7)) << 4);
    const int nunits = nunits_lat + nunits_ctx;
    int bid_ = blockIdx.x; asm volatile("" : "+s"(bid_));
    const int gsz_ = gridDim.x; const int vcu_ = (gsz_ % 8 == 0) ? (bid_ % 8) * (gsz_ / 8) + bid_ / 8 : bid_;
    for (int u = vcu_; u < nunits; u += gsz_) {
        const bool isctx = u >= nunits_lat; int b, hq, qrow0;
        if (!GQA) { int qb; if (!isctx) { qb = u & 15; hq = (u >> 4) & 15; b = u >> 8; } else { const int v = u - nunits_lat; hq = v & 15; b = v >> 4; qb = 0; } qrow0 = qb * 256 + wave * 32; }
        else { int qb64, kvh; if (!isctx) { qb64 = u & 63; kvh = (u >> 6) & 3; b = u >> 8; } else { const int v = u - nunits_lat; qb64 = v & 3; kvh = (v >> 2) & 3; b = v >> 4; } hq = kvh * 4 + (wave >> 1); qrow0 = qb64 * 64 + (wave & 1) * 32; }
        const int ublk0 = GQA ? (qrow0 & ~63) : (qrow0 & ~255), ublen = GQA ? 64 : 256;
        const int mqw = (isctx ? TL + b * CTXL : b * SEQ) + qrow0;
        int lt0 = 0, nlt = 0;
        if (!isctx) { if (WINDOW) { const int lo = (ublk0 - 128) < 0 ? 0 : (ublk0 - 128); const int hi = (ublk0 + ublen + 128) > SEQ ? SEQ : (ublk0 + ublen + 128); lt0 = lo >> 6; nlt = (hi - lo) >> 6; } else { lt0 = 0; nlt = 64; } }
        const int nt = 4 + nlt;
        bf16x8 qf[NKS];
        { const bf16* qp = Q + (size_t)(mqw + r32) * ldq + hq * DQ + 8 * hh;
#pragma unroll
          for (int ks = 0; ks < NKS; ++ks) qf[ks] = *(const bf16x8*)(qp + 16 * ks); }
        float m_run, l_run;
        m_run = 0.f; l_run = (sink && hh == 0) ? __builtin_amdgcn_exp2f(sink[hq] * LOG2E) : 0.f;
        f32x16 o[NV];
#pragma unroll
        for (int v = 0; v < NV; ++v)
#pragma unroll
            for (int i = 0; i < 16; ++i) o[v][i] = 0.f;
        const bf16* kbase = K1 + (size_t)(hq >> kshift) * 64;
        const bf16* vbase = Vt + (size_t)((hq >> vshift) * DV) * MT;
        bf16x8 pf[2]; f32x16 s1k; bool pact = true;
#pragma unroll
        for (int i = 0; i < 16; ++i) s1k[i] = 0.f;
#define AT_M0(t) ((t) < 4 ? (TL + b * CTXL + 64 * (t)) : (b * SEQ + (lt0 + (t) - 4) * 64))
#define AT_DMA(src_, dst_) __builtin_amdgcn_global_load_lds((const unsigned*)(src_), (LAS unsigned*)(dst_), 16, 0, 0)
#define AT_LOADK(t, sl) do { const int m0_ = AT_M0(t); LAS unsigned char* kd_ = lds + AT_K0 + (sl) * AT_KB; \
        if (DQ == 64) { const int row = 8 * wave + (lane >> 3), c = (lane & 7) ^ ((row >> 1) & 7); AT_DMA(kbase + (size_t)(m0_ + row) * ldk + 8 * c, kd_ + 1024 * wave); } \
        else { _Pragma("unroll") for (int i = 0; i < 2; ++i) { const int piece = (i == 0) ? wave : (wave < 4 ? wave + 8 : wave); const int o_ = 1024 * piece + 16 * lane; \
                 const int row = o_ / 192, c = ((o_ % 192) >> 4) ^ ((row >> 2) & 3); \
                 const bf16* src = (c < 8) ? kbase + (size_t)(m0_ + row) * ldk + 8 * c : KR + (size_t)(m0_ + row) * 32 + 8 * (c - 8); AT_DMA(src, kd_ + 1024 * piece); } } } while (0)
#define AT_LOADV(t, sl) do { const int m0_ = AT_M0(t); LAS unsigned char* vd_ = lds + AT_V0 + (sl) * AT_VB; \
        _Pragma("unroll") for (int i = 0; i < NVL; ++i) { const int piece = wave + 8 * i; const int row = 8 * piece + (lane >> 3), c16 = (lane & 7) ^ ((row >> 1) & 7); \
            AT_DMA(vbase + (size_t)row * MT + m0_ + 8 * c16, vd_ + 1024 * piece); } } while (0)
#define AT_VMW(n) asm volatile("s_waitcnt vmcnt(%0)" :: "n"(n) : "memory")
#define AT_QKS(te, sl) do { \
        bool active = true; int kpos0 = 0; const bool lat_tile = (te) >= 4; \
        if (lat_tile) kpos0 = (lt0 + (te) - 4) * 64; \
        if (WINDOW && lat_tile) { const int qa = qrow0; active = (kpos0 + 63 >= qa - 128) && (kpos0 <= qa + 31 + 128); } \
        pact = active; \
        if (active) { \
            const LAS unsigned char* kb = lds + AT_K0 + (sl) * AT_KB; \
            f32x16 s0, s1; bf16x8 ka[NKS][2]; \
            _Pragma("unroll") for (int ks = 0; ks < NKS; ++ks) { ka[ks][0] = *(const LAS bf16x8*)(kb + koff[ks]); ka[ks][1] = *(const LAS bf16x8*)(kb + koff[ks] + 32 * KROWB); } \
            __builtin_amdgcn_sched_barrier(0); \
            { f32x16 z_; _Pragma("unroll") for (int i = 0; i < 16; ++i) z_[i] = 0.f; \
              s0 = __builtin_amdgcn_mfma_f32_32x32x16_bf16(ka[0][0], qf[0], z_, 0, 0, 0); s1 = __builtin_amdgcn_mfma_f32_32x32x16_bf16(ka[0][1], qf[0], z_, 0, 0, 0); } \
            _Pragma("unroll") for (int ks = 1; ks < NKS; ++ks) { s0 = __builtin_amdgcn_mfma_f32_32x32x16_bf16(ka[ks][0], qf[ks], s0, 0, 0, 0); s1 = __builtin_amdgcn_mfma_f32_32x32x16_bf16(ka[ks][1], qf[ks], s1, 0, 0, 0); } \
            __builtin_amdgcn_sched_barrier(0); \
            if (__any(m_run != 0.f)) { _Pragma("unroll") for (int i = 0; i < 16; ++i) { s0[i] -= m_run; s1[i] -= m_run; } }     \
            if (WINDOW && lat_tile) { \
                const int qp = qrow0 + r32; float negbig = -1e30f; asm volatile("" : "+v"(negbig)); \
                _Pragma("unroll") for (int i = 0; i < 16; ++i) { const int kr = kpos0 + (i & 3) + 4 * ((i >> 2) & 1) + 8 * hh + 16 * (i >> 3); const int d0 = qp - kr, d1 = qp - (kr + 32); \
                    if (d0 > 128 || d0 < -128) s0[i] = negbig; if (d1 > 128 || d1 < -128) s1[i] = negbig; } \
            } \
            float mx = s0[0]; \
            _Pragma("unroll") for (int i = 1; i < 16; ++i) mx = fmaxf(mx, s0[i]); \
            _Pragma("unroll") for (int i = 0; i < 16; ++i) mx = fmaxf(mx, s1[i]); \
            mx = fmaxf(mx, xor32(mx, hh)); \
            if (__any(mx > AT_THR)) { \
                const float delta = fmaxf(mx, 0.f); const float alpha = __builtin_amdgcn_exp2f(-delta); \
                m_run += delta; l_run *= alpha; \
                _Pragma("unroll") for (int i = 0; i < 16; ++i) { s0[i] -= delta; s1[i] -= delta; } \
                _Pragma("unroll") for (int v = 0; v < NV; ++v) _Pragma("unroll") for (int i = 0; i < 16; ++i) o[v][i] *= alpha; \
            } \
            float ps = 0.f; \
            _Pragma("unroll") for (int i = 0; i < 16; ++i) { s0[i] = __builtin_amdgcn_exp2f(s0[i]); ps += s0[i]; } \
            l_run += ps; \
            { u32x4 w; w.x = pk2(s0[0], s0[1]); w.y = pk2(s0[2], s0[3]); w.z = pk2(s0[4], s0[5]); w.w = pk2(s0[6], s0[7]); pf[0] = __builtin_bit_cast(bf16x8, w); \
              w.x = pk2(s0[8], s0[9]); w.y = pk2(s0[10], s0[11]); w.z = pk2(s0[12], s0[13]); w.w = pk2(s0[14], s0[15]); pf[1] = __builtin_bit_cast(bf16x8, w); } \
            s1k = s1; \
        } } while (0)
#define AT_PV(te, sl) do { if (pact) { \
            __builtin_amdgcn_s_setprio(1);     \
            const LAS unsigned char* vb = lds + AT_V0 + (sl) * AT_VB; \
            bf16x8 vfa[NV][2]; \
            _Pragma("unroll") for (int v = 0; v < NV; ++v) { vfa[v][0] = *(const LAS bf16x8*)(vb + 32 * 128 * v + voff[0]); vfa[v][1] = *(const LAS bf16x8*)(vb + 32 * 128 * v + voff[1]); } \
            __builtin_amdgcn_sched_barrier(0); \
            _Pragma("unroll") for (int v = 0; v < NV; ++v) { o[v] = __builtin_amdgcn_mfma_f32_32x32x16_bf16(vfa[v][0], pf[0], o[v], 0, 0, 0); o[v] = __builtin_amdgcn_mfma_f32_32x32x16_bf16(vfa[v][1], pf[1], o[v], 0, 0, 0); } \
            __builtin_amdgcn_sched_barrier(0); \
            _Pragma("unroll") for (int v = 0; v < NV; ++v) { vfa[v][0] = *(const LAS bf16x8*)(vb + 32 * 128 * v + voff[2]); vfa[v][1] = *(const LAS bf16x8*)(vb + 32 * 128 * v + voff[3]); } \
            bf16x8 pf2, pf3; \
            { float ps = 0.f; \
              _Pragma("unroll") for (int i = 0; i < 16; ++i) { s1k[i] = __builtin_amdgcn_exp2f(s1k[i]); ps += s1k[i]; } \
              l_run += ps; \
              u32x4 w; w.x = pk2(s1k[0], s1k[1]); w.y = pk2(s1k[2], s1k[3]); w.z = pk2(s1k[4], s1k[5]); w.w = pk2(s1k[6], s1k[7]); pf2 = __builtin_bit_cast(bf16x8, w); \
              w.x = pk2(s1k[8], s1k[9]); w.y = pk2(s1k[10], s1k[11]); w.z = pk2(s1k[12], s1k[13]); w.w = pk2(s1k[14], s1k[15]); pf3 = __builtin_bit_cast(bf16x8, w); } \
            __builtin_amdgcn_sched_barrier(0); \
            _Pragma("unroll") for (int v = 0; v < NV; ++v) { o[v] = __builtin_amdgcn_mfma_f32_32x32x16_bf16(vfa[v][0], pf2, o[v], 0, 0, 0); o[v] = __builtin_amdgcn_mfma_f32_32x32x16_bf16(vfa[v][1], pf3, o[v], 0, 0, 0); } \
            __builtin_amdgcn_sched_barrier(0); \
            __builtin_amdgcn_s_setprio(0); \
        } } while (0)
        int k0_ = 0, k1_ = 1, k2_ = 2;
        AT_LOADK(0, 0); AT_LOADV(0, 0); AT_LOADK(1, 1); AT_LOADV(1, 1); AT_VMW(NKL + NVL); AT_BAR();
        if (grp == 0) {
            for (int t = 0; t < nt; ++t) {
                const bool deep = t + 2 < nt;
                if (deep) { AT_LOADK(t + 2, k2_); AT_LOADV(t + 2, (t + 2) & 3); }
                AT_QKS(t, k0_);
                AT_PV(t, t & 3);
                if (deep) AT_VMW(NKL + NVL); else AT_VMW(0);
                AT_BAR();
                { const int r_ = k0_; k0_ = k1_; k1_ = k2_; k2_ = r_; }
            }
            AT_BAR();
        } else {
            { const bool deep = 2 < nt; if (deep) { AT_LOADK(2, k2_); AT_LOADV(2, 2); }
              AT_QKS(0, k0_);
              if (deep) AT_VMW(NKL + NVL); else AT_VMW(0);
              AT_BAR();
              { const int r_ = k0_; k0_ = k1_; k1_ = k2_; k2_ = r_; } }
            for (int t = 1; t < nt; ++t) {
                const bool deep = t + 2 < nt;
                if (deep) { AT_LOADK(t + 2, k2_); AT_LOADV(t + 2, (t + 2) & 3); }
                AT_PV(t - 1, (t - 1) & 3);
                AT_QKS(t, k0_);
                if (deep) AT_VMW(NKL + NVL); else AT_VMW(0);
                AT_BAR();
                { const int r_ = k0_; k0_ = k1_; k1_ = k2_; k2_ = r_; }
            }
            AT_PV(nt - 1, (nt - 1) & 3);
            AT_BAR();
        }
        const float lt = l_run + xor32(l_run, hh); const float inv = 1.f / lt;
        bf16* op = O + (size_t)(mqw + r32) * ldo + hq * DV + 8 * hh;
#pragma unroll
        for (int v = 0; v < NV; ++v)
#pragma unroll
            for (int g = 0; g < 4; g += 2) {
                unsigned ax = pk2(o[v][4 * g] * inv, o[v][4 * g + 1] * inv), ay = pk2(o[v][4 * g + 2] * inv, o[v][4 * g + 3] * inv);
                unsigned bx = pk2(o[v][4 * g + 4] * inv, o[v][4 * g + 5] * inv), by = pk2(o[v][4 * g + 6] * inv, o[v][4 * g + 7] * inv);
                auto r0 = __builtin_amdgcn_permlane32_swap(ax, bx, false, false); auto r1 = __builtin_amdgcn_permlane32_swap(ay, by, false, false);
                u32x4 w; w.x = r0[0]; w.y = r1[0]; w.z = r0[1]; w.w = r1[1];
                *(u32x4*)(op + 32 * v + 8 * g) = w; }
#undef AT_M0
#undef AT_LOADK
#undef AT_LOADV
#undef AT_DMA
#undef AT_VMW
#undef AT_QKS
#undef AT_PV
    }
}
__device__ __forceinline__ void post_pass(int gw, int ngw, int lane, const bf16* __restrict__ Y, const float* __restrict__ gY, const float* __restrict__ modsY, int gate_idx,
                                          const float* hin_lat, const float* hin_ctx, float* hout_lat, float* hout_ctx,
                                          bf16* __restrict__ U, const float* __restrict__ gU, const float* __restrict__ modsU, int shift_idx, int scale_idx, int nrows,
                                          const bf16* __restrict__ Yp = nullptr, int nparts = 0, int row_begin = 0) {
    float eps_ = EPS; asm volatile("" : "+v"(eps_));
    for (int r = row_begin + gw; r < nrows; r += ngw) {
        const bool lat = r < TL; const int mb = lat ? (r >> 12) : 8;
        const float* hi_ = lat ? hin_lat + (size_t)r * D : hin_ctx + (size_t)(r - TL) * D;
        f32x4 h[4];
#pragma unroll
        for (int j = 0; j < 4; ++j) h[j] = *(const f32x4*)(hi_ + 256 * j + 4 * lane);
        if (Y) {
            f32x4 y[4]; float ss = 0.f;
            if (Yp && !lat) {
#pragma unroll
                for (int j = 0; j < 4; ++j) y[j] = (f32x4){0.f, 0.f, 0.f, 0.f};
                for (int k = 0; k < nparts; ++k) { const bf16* yr = Yp + ((size_t)k * TC + (r - TL)) * D;
#pragma unroll
                    for (int j = 0; j < 4; ++j) { const u32x2 w = *(const u32x2*)(yr + 256 * j + 4 * lane); y[j] = y[j] + (f32x4){bflo(w.x), bfhi(w.x), bflo(w.y), bfhi(w.y)}; } }
            } else { const bf16* yr = Y + (size_t)r * D;
#pragma unroll
                for (int j = 0; j < 4; ++j) { const u32x2 w = *(const u32x2*)(yr + 256 * j + 4 * lane); y[j] = (f32x4){bflo(w.x), bfhi(w.x), bflo(w.y), bfhi(w.y)}; } }
#pragma unroll
            for (int j = 0; j < 4; ++j) ss += (y[j][0] * y[j][0] + y[j][1] * y[j][1]) + (y[j][2] * y[j][2] + y[j][3] * y[j][3]);
            const float rs = rsqrtf(wave_sum(ss, lane) * (1.f / D) + eps_);
            const float* gt = modsY + (size_t)mb * 6144 + gate_idx * D;
            float* ho = lat ? hout_lat + (size_t)r * D : hout_ctx + (size_t)(r - TL) * D;
#pragma unroll
            for (int j = 0; j < 4; ++j) { const f32x4 g = *(const f32x4*)(gY + 256 * j + 4 * lane); const f32x4 ga = *(const f32x4*)(gt + 256 * j + 4 * lane);
                h[j] = h[j] + ga * (y[j] * rs * g); *(f32x4*)(ho + 256 * j + 4 * lane) = h[j]; }
        }
        if (U) {
            float ss = 0.f;
#pragma unroll
            for (int j = 0; j < 4; ++j) ss += (h[j][0] * h[j][0] + h[j][1] * h[j][1]) + (h[j][2] * h[j][2] + h[j][3] * h[j][3]);
            const float rs = rsqrtf(wave_sum(ss, lane) * (1.f / D) + eps_);
            const float* sh = modsU + (size_t)mb * 6144 + shift_idx * D; const float* sc = modsU + (size_t)mb * 6144 + scale_idx * D;
            bf16* ur = U + (size_t)r * D;
#pragma unroll
            for (int j = 0; j < 4; ++j) { const f32x4 g = *(const f32x4*)(gU + 256 * j + 4 * lane); const f32x4 s1 = *(const f32x4*)(sc + 256 * j + 4 * lane); const f32x4 s0 = *(const f32x4*)(sh + 256 * j + 4 * lane);
                const f32x4 v = (h[j] * rs * g) * (s1 + 1.f) + s0; u32x2 w; w.x = pk2(v[0], v[1]); w.y = pk2(v[2], v[3]); *(u32x2*)(ur + 256 * j + 4 * lane) = w; }
        }
    }
}
__device__ __forceinline__ void diff_combine(int gw, int ngw, int lane, const bf16* __restrict__ OB, bf16* __restrict__ ATT, const float* __restrict__ lam, const float* __restrict__ subln, float lam_init) {
    const float p1 = wave_sum(lam[lane] * lam[64 + lane], lane), p2 = wave_sum(lam[128 + lane] * lam[192 + lane], lane);
    const float lam_full = expf(p1) - expf(p2) + lam_init;
    const int hd = lane >> 3, j0 = (lane & 7) * 16;
    float g[16];
#pragma unroll
    for (int e = 0; e < 16; ++e) g[e] = subln[j0 + e] * (1.f - lam_init);
    for (int r = gw; r < MT; r += ngw) {
        const bf16* p = OB + (size_t)r * 2048 + hd * 256 + j0;
        const u32x4 a0 = *(const u32x4*)p, a1 = *(const u32x4*)(p + 8), b0 = *(const u32x4*)(p + 128), b1 = *(const u32x4*)(p + 136);
        const unsigned aw[8] = {a0.x, a0.y, a0.z, a0.w, a1.x, a1.y, a1.z, a1.w}, bw[8] = {b0.x, b0.y, b0.z, b0.w, b1.x, b1.y, b1.z, b1.w};
        float o[16]; float ss = 0.f;
#pragma unroll
        for (int e = 0; e < 8; ++e) { o[2 * e] = bflo(aw[e]) - lam_full * bflo(bw[e]); o[2 * e + 1] = bfhi(aw[e]) - lam_full * bfhi(bw[e]); ss += o[2 * e] * o[2 * e] + o[2 * e + 1] * o[2 * e + 1]; }
        ss += shx(ss, 1, lane); ss += shx(ss, 2, lane); ss += shx(ss, 4, lane);
        const float rs = rsqrtf(ss * (1.f / 128.f) + EPS);
        u32x4 w0, w1;
        w0.x = pk2(o[0] * rs * g[0], o[1] * rs * g[1]); w0.y = pk2(o[2] * rs * g[2], o[3] * rs * g[3]); w0.z = pk2(o[4] * rs * g[4], o[5] * rs * g[5]); w0.w = pk2(o[6] * rs * g[6], o[7] * rs * g[7]);
        w1.x = pk2(o[8] * rs * g[8], o[9] * rs * g[9]); w1.y = pk2(o[10] * rs * g[10], o[11] * rs * g[11]); w1.z = pk2(o[12] * rs * g[12], o[13] * rs * g[13]); w1.w = pk2(o[14] * rs * g[14], o[15] * rs * g[15]);
        bf16* q = ATT + (size_t)r * D + hd * 128 + j0; *(u32x4*)q = w0; *(u32x4*)(q + 8) = w1;
    }
}
__device__ __forceinline__ void mla_norm(int gw, int ngw, int lane, bf16* __restrict__ CQ, bf16* __restrict__ KR, const float* __restrict__ qn, const float* __restrict__ kvn, const float* __restrict__ tab32) {
    for (int r = gw; r < MT; r += ngw) {
        bf16* row = CQ + (size_t)r * 768;
        unsigned* cq = (unsigned*)(row + 6 * lane); unsigned a0 = cq[0], a1 = cq[1], a2 = cq[2];
        float x[6] = {bflo(a0), bfhi(a0), bflo(a1), bfhi(a1), bflo(a2), bfhi(a2)}; float ss = 0.f;
#pragma unroll
        for (int e = 0; e < 6; ++e) ss += x[e] * x[e];
        float rs = rsqrtf(wave_sum(ss, lane) * (1.f / 384.f) + EPS);
#pragma unroll
        for (int e = 0; e < 6; ++e) x[e] = x[e] * rs * qn[6 * lane + e];
        cq[0] = pk2(x[0], x[1]); cq[1] = pk2(x[2], x[3]); cq[2] = pk2(x[4], x[5]);
        u32x2* ck = (u32x2*)(row + 384 + 4 * lane); u32x2 b = *ck; float y[4] = {bflo(b.x), bfhi(b.x), bflo(b.y), bfhi(b.y)};
        ss = y[0] * y[0] + y[1] * y[1] + y[2] * y[2] + y[3] * y[3];
        rs = rsqrtf(wave_sum(ss, lane) * (1.f / 256.f) + EPS);
#pragma unroll
        for (int e = 0; e < 4; ++e) y[e] = y[e] * rs * kvn[4 * lane + e];
        b.x = pk2(y[0], y[1]); b.y = pk2(y[2], y[3]); *ck = b;
        const int l = lane & 31; const float v = __uint_as_float((unsigned)row[640 + l] << 16);
        const float p = shx(v, 8, lane);
        float outv = v;
        if (r < TL) { const int s = r & 4095; const int pos = (l & 16) ? (s & 63) : (s >> 6); const float cs = tab32[(pos * 8 + (l & 7)) * 2], sn = tab32[(pos * 8 + (l & 7)) * 2 + 1];
            outv = (l & 8) ? v * cs + p * sn : v * cs - p * sn; }
        const float nb = shx(outv, 1, lane);
        if (lane < 32 && !(lane & 1)) *(unsigned*)(KR + (size_t)r * 32 + lane) = pk2(outv, nb);
    }
}
__device__ __forceinline__ void conv_tile(LAS float* scr, const float* __restrict__ src, int N, int k0, int c0, bf16* __restrict__ dst, int ldd, int drow0, int tid) {
    const int nn = tid & 63, kq = tid >> 6;
#pragma unroll
    for (int i = 0; i < 8; ++i) { const int kk = kq + 8 * i; scr[kk * 65 + nn] = (c0 + nn < N) ? src[(size_t)(k0 + kk) * N + c0 + nn] : 0.f; }
    __syncthreads();
    const int n = tid >> 3, kc = tid & 7; const LAS float* s = scr + (8 * kc) * 65 + n;
    u32x4 o; o.x = pk2(s[0], s[65]); o.y = pk2(s[2 * 65], s[3 * 65]); o.z = pk2(s[4 * 65], s[5 * 65]); o.w = pk2(s[6 * 65], s[7 * 65]);
    *(u32x4*)(dst + (size_t)(drow0 + n) * ldd + k0 + 8 * kc) = o;
    __syncthreads();
}
__device__ __forceinline__ void conv_layer(LAS unsigned char* lds, const LayerPtrs& L, int kind, bf16* W, int tid) {
    LAS float* scr = (LAS float*)lds;
    bf16* mix = W + WO_MIX;
    const int n_w1 = 16 * 64, n_w2 = 64 * 16, n_wo = 16 * 16;
    int n_a, n_uq = 0, n_ukv = 0;
    if (kind == 0) n_a = 16 * 24; else if (kind == 1) n_a = 16 * 48; else { n_a = 16 * 12; n_uq = 6 * 24; n_ukv = 4 * 32; }
    const int total = n_w1 + n_w2 + n_wo + n_a + n_uq + n_ukv;
    const int nn = tid & 63, kq = tid >> 6;
#define CJ_DECODE(r_in, SRC, NN, K0, C0, DST, LDD, DR0) do { int r = (r_in); \
        if (r < n_w1) { SRC = L.w1; NN = FF; K0 = (r / 64) * 64; C0 = (r % 64) * 64; DST = W + WO_W1; LDD = D; DR0 = (r % 64) * 64; } \
        else if ((r -= n_w1) < n_w2) { SRC = L.w2; NN = D; K0 = (r / 16) * 64; C0 = (r % 16) * 64; DST = W + WO_W2; LDD = FF; DR0 = (r % 16) * 64; } \
        else if ((r -= n_w2) < n_wo) { SRC = L.w_o; NN = D; K0 = (r / 16) * 64; C0 = (r % 16) * 64; DST = W + WO_WO; LDD = D; DR0 = (r % 16) * 64; } \
        else if ((r -= n_wo) < n_a) { SRC = L.w_a; LDD = D; \
            if (kind == 0) { const int kt = r / 24, tn = r % 24; NN = 1536; K0 = kt * 64; C0 = tn * 64; DST = tn < 20 ? mix : mix + (size_t)1280 * D; DR0 = tn < 20 ? tn * 64 : (tn - 20) * 64; } \
            else if (kind == 1) { const int kt = r / 48, tn = r % 48; NN = 3072; K0 = kt * 64; C0 = tn * 64; DST = tn < 32 ? mix : mix + (size_t)2048 * D; DR0 = tn < 32 ? tn * 64 : (tn - 32) * 64; } \
            else { const int kt = r / 12, tn = r % 12; NN = 672; K0 = kt * 64; C0 = tn * 64; DST = mix; DR0 = tn * 64; } } \
        else if ((r -= n_a) < n_uq) { const int kt = r / 24, tn = r % 24; SRC = L.w_uq; NN = 1536; K0 = kt * 64; C0 = tn * 64; DST = mix + (size_t)768 * D; LDD = 384; DR0 = tn * 64; } \
        else { r -= n_uq; const int kt = r / 32, tn = r % 32; SRC = L.w_ukv; NN = 2048; K0 = kt * 64; C0 = tn * 64; \
               DST = mix + (size_t)768 * D + (size_t)1536 * 384 + ((tn & 1) ? (size_t)1024 * 256 : 0); LDD = 256; DR0 = (tn >> 1) * 64; } } while (0)
#define CJ_LOAD(V, SRC, NN, K0, C0) do { _Pragma("unroll") for (int i = 0; i < 8; ++i) V[i] = ((C0) + nn < (NN)) ? (SRC)[(size_t)((K0) + kq + 8 * i) * (NN) + (C0) + nn] : 0.f; } while (0)
    int bid_ = blockIdx.x; asm volatile("" : "+s"(bid_));
    const int gsz = gridDim.x;
    int it = bid_;
    const float* src = nullptr; int N = 0, k0 = 0, c0 = 0, ldd = 0, drow0 = 0; bf16* dst = nullptr;
    float v[8];
    if (it < total) { CJ_DECODE(it, src, N, k0, c0, dst, ldd, drow0); CJ_LOAD(v, src, N, k0, c0); }
    while (it < total) {
#pragma unroll
        for (int i = 0; i < 8; ++i) scr[(kq + 8 * i) * 65 + nn] = v[i];
        const int itn = it + gsz;
        const float* srcn = nullptr; int Nn = 0, k0n = 0, c0n = 0, lddn = 0, drow0n = 0; bf16* dstn = nullptr;
        if (itn < total) { CJ_DECODE(itn, srcn, Nn, k0n, c0n, dstn, lddn, drow0n); CJ_LOAD(v, srcn, Nn, k0n, c0n); }
        __syncthreads();
        { const int n = tid >> 3, kc = tid & 7; const LAS float* sp = scr + (8 * kc) * 65 + n;
          u32x4 o; o.x = pk2(sp[0], sp[65]); o.y = pk2(sp[2 * 65], sp[3 * 65]); o.z = pk2(sp[4 * 65], sp[5 * 65]); o.w = pk2(sp[6 * 65], sp[7 * 65]);
          *(u32x4*)(dst + (size_t)(drow0 + n) * ldd + k0 + 8 * kc) = o; }
        __syncthreads();
        it = itn; src = srcn; N = Nn; k0 = k0n; c0 = c0n; dst = dstn; ldd = lddn; drow0 = drow0n;
    }
#undef CJ_DECODE
#undef CJ_LOAD
}
__device__ __forceinline__ void mods_phase(LAS unsigned char* lds, const Params& p, float* mods, int tid) {
    LAS float* sc = (LAS float*)lds;
    LAS float* red = (LAS float*)(lds + 9 * 1024 * 4);
    for (int idx = tid; idx < 9 * 1024; idx += NTHREADS) { const int bb = idx >> 10, k = idx & 1023; const float v = bb < 8 ? p.c[bb * 1024 + k] : p.c_ctx[k]; sc[idx] = v / (1.f + __expf(-v)); }
    __syncthreads();
    const int col = tid & 63, kg = tid >> 6;
    int bid_ = blockIdx.x; asm volatile("" : "+s"(bid_));
    for (int it = bid_; it < 4 * 96; it += gridDim.x) {
        const int l = it / 96, n0 = (it % 96) * 64;
        const float* aw = p.L[l].ada_w; const float* ab = p.L[l].ada_b;
        float acc[9];
#pragma unroll
        for (int bb = 0; bb < 9; ++bb) acc[bb] = 0.f;
        const float* wp = aw + (size_t)(kg * 128) * 6144 + n0 + col;
#pragma unroll 32
        for (int k = 0; k < 128; ++k) { const float w = wp[(size_t)k * 6144];
#pragma unroll
            for (int bb = 0; bb < 9; ++bb) acc[bb] += sc[bb * 1024 + kg * 128 + k] * w; }
#pragma unroll
        for (int bb = 0; bb < 9; ++bb) red[(kg * 9 + bb) * 64 + col] = acc[bb];
        __syncthreads();
        for (int o = tid; o < 576; o += NTHREADS) { const int bb = o >> 6, c = o & 63; float s = 0.f;
#pragma unroll
            for (int g = 0; g < 8; ++g) s += red[(g * 9 + bb) * 64 + c];
            mods[(size_t)l * MODS_PER_LAYER + bb * 6144 + n0 + c] = s + ab[n0 + c]; }
        __syncthreads();
    }
}
__device__ __forceinline__ void tables_phase(float* tab64, float* tab32) {
    const int g = blockIdx.x * NTHREADS + threadIdx.x;
    if (g < 1024) { const int pos = g >> 4, i = g & 15; const float inv = powf(10000.f, -(float)i / 16.f); const float a = (float)pos * inv; tab64[2 * g] = cosf(a); tab64[2 * g + 1] = sinf(a); }
    else if (g < 1536) { const int h = g - 1024; const int pos = h >> 3, i = h & 7; const float inv = powf(10000.f, -(float)i / 8.f); const float a = (float)pos * inv; tab32[2 * h] = cosf(a); tab32[2 * h + 1] = sinf(a); }
}

constexpr int REP_A = 1, REP_B = 1, REP_C = 1, REP_MLP = 1, REP_SYNC = 0, REP_P1 = 1, REP_P0 = 1;
template <class Epi> __device__ __forceinline__ void run_gemm(LAS unsigned char* lds, const bf16* A, int lda, const bf16* Bt, int ldb, int M, int N, int K, const Epi& E, int cidx = -1) {
    pg8::Gemm g{A, Bt, M, N, K, lda, ldb}; int bid_ = blockIdx.x, gd_ = gridDim.x; asm volatile("" : "+s"(bid_), "+s"(gd_)); pg8::StaticOrder S; S.init(M, N, gd_, cidx >= 0 ? cidx : bid_);
    pg8::gemm_phase<Epi, pg8::StaticOrder, true, true>((PG8_LAS unsigned char*)lds, g, S, E);
}

__global__ void __launch_bounds__(NTHREADS, 2) fwd_megakernel(Params p) {
    extern __shared__ __attribute__((aligned(16))) unsigned char lds_raw[];
    LAS unsigned char* lds = (LAS unsigned char*)lds_raw;
    cg::grid_group grid = cg::this_grid();
    volatile LAS unsigned* xb_st = (volatile LAS unsigned*)(lds + 139264);
    if (threadIdx.x == 0) { xb_st[0] = 0u; xb_st[1] = 0u; }
    __syncthreads();
    (void)xcd_barrier_post((unsigned*)(p.ws + WS_XBAR), xb_st);
#define GSYNC() do { size_t zb_ = 0; asm volatile("" : "+s"(zb_)); XcdBarrier xb_; xb_.bar = (unsigned*)(p.ws + WS_XBAR + zb_); xb_.x = xb_xcc_id(); xb_.st = (volatile LAS unsigned*)(lds + 139264); xcd_barrier(xb_); } while (0)
    int tid, lane, wave, gw; const int ngw = gridDim.x * NWAVES;
#define FRESH() do { int t_ = threadIdx.x; asm volatile("" : "+v"(t_)); tid = t_; lane = tid & 63; wave = __builtin_amdgcn_readfirstlane(tid >> 6); int b_ = blockIdx.x; asm volatile("" : "+s"(b_)); gw = b_ * NWAVES + wave; } while (0)
#define DERIVE() size_t z_ = 0; asm volatile("" : "+s"(z_)); unsigned char* ws = p.ws + z_; \
    float* tab64 = (float*)(ws + WS_TAB); float* tab32 = (float*)(ws + WS_TAB + 8192); float* mods = (float*)(ws + WS_MODS); float* HC = (float*)(ws + WS_HC); \
    bf16* KR = (bf16*)(ws + WS_KR); bf16* U = (bf16*)(ws + WS_U); bf16* Y = (bf16*)(ws + WS_Y); bf16* BIG = (bf16*)(ws + WS_BIG); \
    (void)tab64; (void)tab32; (void)mods; (void)HC; (void)KR; (void)U; (void)Y; (void)BIG
#define DERIVE_L() DERIVE(); bf16* W = (bf16*)(ws + WS_W + (size_t)(l & 1) * WS_WSTRIDE); bf16* mix = W + WO_MIX; const float* modsl = mods + (size_t)l * MODS_PER_LAYER; (void)mix; (void)modsl
    FRESH();
    for (int rep = 0; rep < REP_P0; ++rep) { DERIVE();
      tables_phase(tab64, tab32);
      mods_phase(lds, p, mods, tid);
      conv_layer(lds, p.L[0], 0, (bf16*)(ws + WS_W), tid); }
    if (p.ws == nullptr) grid.sync();
    GSYNC(); FRESH();
    for (int rep = 0; rep < REP_SYNC; ++rep) GSYNC();
    for (int rep = 0; rep < REP_P1; ++rep) { DERIVE(); post_pass(gw, ngw, lane, nullptr, nullptr, nullptr, 0, p.x, p.ctx, nullptr, nullptr, U, p.L[0].norms, mods, 0, 1, MT); }
    GSYNC(); FRESH();

#pragma unroll 1
    for (int l = 0; l < 4; ++l) {
        const int kind = l % 3;
        if (kind == 0) {
            { DERIVE_L(); bf16* Qb = BIG; bf16* Kb = BIG + (size_t)MT * 1024; bf16* Vt = Kb + (size_t)MT * 256;
              { pg8::EpiRope<0> E{Qb, 1024, 1024, Kb, 256, 0.125f * LOG2E, tab64, TL}; run_gemm(lds, U, D, mix, D, MT, 1280, D, E); }
              { pg8::EpiStore E{Vt, MT, 0, nullptr, 0, 0}; run_gemm(lds, mix + (size_t)1280 * D, D, U, D, 256, MT, D, E); } }
            GSYNC(); FRESH();
            { DERIVE_L(); bf16* Qb = BIG; bf16* Kb = BIG + (size_t)MT * 1024; bf16* Vt = Kb + (size_t)MT * 256;
              for (int rep = 0; rep < REP_A; ++rep) attn_phase<64, 64, true, true>(lds, Qb, 1024, Kb, 256, 2, nullptr, Vt, 2, U, 1024, p.L[l].x0, 2048, 128); }
            GSYNC(); FRESH();
        } else if (kind == 1) {
            { DERIVE_L(); bf16* Qb = BIG; bf16* Kb = BIG + (size_t)MT * 1024; bf16* Vt = Kb + (size_t)MT * 1024;
              { pg8::EpiRope<0> E{Qb, 1024, 1024, Kb, 1024, 0.125f * LOG2E, tab64, TL}; run_gemm(lds, U, D, mix, D, MT, 2048, D, E); }
              { pg8::EpiStore E{Vt, MT, 0, nullptr, 0, 0}; run_gemm(lds, mix + (size_t)2048 * D, D, U, D, 1024, MT, D, E, (int)((blockIdx.x + 256 - 64) & 255)); } }
            GSYNC(); FRESH();
            { DERIVE_L(); bf16* Qb = BIG; bf16* Kb = BIG + (size_t)MT * 1024; bf16* Vt = Kb + (size_t)MT * 1024;
              for (int rep = 0; rep < REP_B; ++rep) attn_phase<64, 128, false>(lds, Qb, 1024, Kb, 1024, 0, nullptr, Vt, 1, U  , 2048, nullptr, 2048, 128); }
            GSYNC(); FRESH();
            { DERIVE_L(); diff_combine(gw, ngw, lane, U, BIG, p.L[l].x0, p.L[l].x1, 0.8f - 0.6f * 0.7408182206817179f); }
            GSYNC(); FRESH();
        } else {
            { DERIVE_L(); pg8::EpiStore E{Y, 768, 0, nullptr, 0, 0}; run_gemm(lds, U, D, mix, D, MT, 768, D, E); }
            GSYNC(); FRESH();
            { DERIVE_L(); mla_norm(gw, ngw, lane, Y, KR, p.L[l].x0, p.L[l].x1, tab32); }
            GSYNC(); FRESH();
            { DERIVE_L(); bf16* CQ = Y; bf16* Qb = BIG; bf16* Kn = BIG + (size_t)MT * 1536; bf16* Vt = Kn + (size_t)MT * 1024;
              const bf16* Wuq = mix + (size_t)768 * D; const bf16* Wkn = Wuq + (size_t)1536 * 384; const bf16* Wv = Wkn + (size_t)1024 * 256;
              { pg8::EpiRope<1> E{Qb, 1536, 0, nullptr, 0, 0.10206207261596575f * LOG2E, tab32, TL}; run_gemm(lds, CQ, 768, Wuq, 384, MT, 1536, 384, E); }
              { pg8::EpiStore E{Kn, 1024, 0, nullptr, 0, 0}; run_gemm(lds, CQ + 384, 768, Wkn, 256, MT, 1024, 256, E, (int)((blockIdx.x + 256 - 48) & 255)); }
              { pg8::EpiStore E{Vt, MT, 0, nullptr, 0, 0}; run_gemm(lds, Wv, 256, CQ + 384, 768, 1024, MT, 256, E, (int)((blockIdx.x + 256 - 80) & 255)); } }
            GSYNC(); FRESH();
            { DERIVE_L(); bf16* Qb = BIG; bf16* Kn = BIG + (size_t)MT * 1536; bf16* Vt = Kn + (size_t)MT * 1024;
              for (int rep = 0; rep < REP_C; ++rep) attn_phase<96, 64, false>(lds, Qb, 1536, Kn, 1024, 0, KR, Vt, 0, U, 1024, nullptr, 2048, 128); }
            GSYNC(); FRESH();
        }
        { DERIVE_L(); const bf16* attn_out = (kind == 1) ? BIG : U; const float* nr = p.L[l].norms;
          { pg8::EpiFuse E{(l == 0) ? p.x : p.out, p.out, U, nr + D, modsl + 2 * D, nr + 2 * D, modsl + 4 * D, modsl + 3 * D,
                           (float*)(ws + WS_XBUF), (unsigned*)(ws + WS_XCNT), 16u * (unsigned)(2 * (2 * l) + 1), (PG8_LAS unsigned char*)(lds + 131072), EPS};
            run_gemm(lds, attn_out, D, W + WO_WO, D, TL, D, D, E); }
          if (l < 3) {
              int kc = blockIdx.x >> 5; asm volatile("" : "+s"(kc)); const int kcc = kc < 4 ? kc : 0;
              pg8::EpiStore E{(bf16*)(ws + WS_YP) + (size_t)kcc * TC * D, D, 0, nullptr, 0, 0};
              run_gemm(lds, attn_out + (size_t)TL * D + kcc * 256, D, W + WO_WO + kcc * 256, D, TC, D, 256, E, kc < 4 ? (int)(blockIdx.x & 31) : (1 << 20)); } }
        GSYNC(); FRESH();
        if (l < 3) {
            { DERIVE_L(); const float* nr = p.L[l].norms;
              post_pass(gw, ngw, lane, Y, nr + D, modsl, 2, p.out, (l == 0) ? p.ctx : HC, p.out, HC, U, nr + 2 * D, modsl, 3, 4, MT, (const bf16*)(ws + WS_YP), 4, TL); }
            GSYNC(); FRESH();
        }
        { DERIVE_L(); pg8::EpiStore E{BIG, FF, 0, nullptr, 0, 1}; run_gemm(lds, U, D, W + WO_W1, D, l < 3 ? MT : TL, FF, D, E); }
        GSYNC(); FRESH();
        { DERIVE_L(); const int ln_ = l < 3 ? l + 1 : l;
          { pg8::EpiFuse E{p.out, p.out, l < 3 ? U : nullptr, p.L[l].norms + 3 * D, modsl + 5 * D, p.L[ln_].norms, modsl + MODS_PER_LAYER + 1 * D, modsl + MODS_PER_LAYER,
                           (float*)(ws + WS_XBUF), (unsigned*)(ws + WS_XCNT), 16u * (unsigned)(2 * (2 * l + 1) + 1), (PG8_LAS unsigned char*)(lds + 131072), EPS};
            run_gemm(lds, BIG, FF, W + WO_W2, FF, TL, D, FF, E); }
          if (l < 3) {
              int kc = blockIdx.x >> 5; asm volatile("" : "+s"(kc)); const int kcc = kc & 7;
              pg8::EpiStore E{(bf16*)(ws + WS_YP) + (size_t)kcc * TC * D, D, 0, nullptr, 0, 0};
              run_gemm(lds, BIG + (size_t)TL * FF + kcc * 512, FF, W + WO_W2 + kcc * 512, FF, TC, D, 512, E, (int)(blockIdx.x & 31)); } }
        if (l < 3) {
            GSYNC(); FRESH();
            { DERIVE_L(); post_pass(gw, ngw, lane, Y, p.L[l].norms + 3 * D, modsl, 5, p.out, HC, p.out, HC, U, p.L[l + 1].norms, modsl + MODS_PER_LAYER, 0, 1, MT, (const bf16*)(ws + WS_YP), 8, TL);
              conv_layer(lds, p.L[l + 1], (l + 1) % 3, (bf16*)(ws + WS_W + (size_t)((l + 1) & 1) * WS_WSTRIDE), tid); }
            GSYNC(); FRESH();
        }
    }
}

extern "C" void kernel_launch(void* const* d_in, const int* in_sizes, int n_in, void* d_out, int out_size, void* d_ws, size_t ws_size, hipStream_t stream) {
    static int grid = 0;
    if (grid == 0) {
        if (n_in != 40 || ws_size < WS_END || out_size != TL * D) { fprintf(stderr, "kernel_launch: unexpected shapes n_in %d ws %zu out %d\n", n_in, ws_size, out_size); grid = -1; return; }
        int dev = 0, cus = 0, per_cu = 0;
        hipGetDevice(&dev); hipDeviceGetAttribute(&cus, hipDeviceAttributeMultiprocessorCount, dev);
        if (hipFuncSetAttribute((const void*)fwd_megakernel, hipFuncAttributeMaxDynamicSharedMemorySize, LDS_BYTES) != hipSuccess) { fprintf(stderr, "hipFuncSetAttribute failed\n"); grid = -1; return; }
        if (hipOccupancyMaxActiveBlocksPerMultiprocessor(&per_cu, (const void*)fwd_megakernel, NTHREADS, LDS_BYTES) != hipSuccess || per_cu < 1) { fprintf(stderr, "occupancy query: %d\n", per_cu); per_cu = 1; }
        (void)hipGetLastError();
        grid = cus * 1;
    }
    if (grid < 0) return;
    Params p{};
    p.x = (const float*)d_in[0]; p.c = (const float*)d_in[1]; p.ctx = (const float*)d_in[2]; p.c_ctx = (const float*)d_in[3];
    p.out = (float*)d_out; p.ws = (unsigned char*)d_ws;
    auto F = [&](int i) { return (const float*)d_in[i]; };
    p.L[0] = LayerPtrs{F(4), F(5), F(6), F(7), F(9), F(10), F(11), F(8), nullptr, nullptr, nullptr};
    p.L[1] = LayerPtrs{F(12), F(13), F(14), F(15), F(18), F(19), F(20), F(16), F(17), nullptr, nullptr};
    p.L[2] = LayerPtrs{F(21), F(22), F(23), F(24), F(29), F(30), F(31), F(25), F(26), F(27), F(28)};
    p.L[3] = LayerPtrs{F(32), F(33), F(34), F(35), F(37), F(38), F(39), F(36), nullptr, nullptr, nullptr};
    (void)hipMemsetAsync((char*)d_ws + WS_XBAR, 0, WS_XCNT + 128 * 256 - WS_XBAR, stream);
    void* args[] = {&p};
    hipError_t e = hipLaunchCooperativeKernel((const void*)fwd_megakernel, dim3(grid), dim3(NTHREADS), args, LDS_BYTES, stream);
    if (e != hipSuccess) fprintf(stderr, "cooperative launch failed: %s (grid %d)\n", hipGetErrorString(e), grid);
}
```
